# Optimizing an MI355X kernel written in HIP

```python
import math
import jax, jax.numpy as jnp
from jax import lax
import numpy as np

D_MODEL = 1024
BATCH = 2
SEQ = 8192
DEPTH = 2

N_MIXERS = 2
EPS = 1e-6

M_HEADS = 8
M_QK_DIM = D_MODEL // (2 * M_HEADS)
M_V_DIM = D_MODEL // M_HEADS
M_CHUNK = 64
GATE_CAP = 15.0
M_IN = 2 * M_HEADS * M_QK_DIM + M_HEADS * M_V_DIM + D_MODEL + 2 * M_HEADS

A_HEAD_DIM = 64
A_Q_HEADS = D_MODEL // A_HEAD_DIM
A_KV_HEADS = 2
A_GROUP = A_Q_HEADS // A_KV_HEADS
WINDOW = 128
A_BLOCK = 128
A_IN = (A_Q_HEADS + 2 * A_KV_HEADS) * A_HEAD_DIM

D_FF = int(math.ceil(8 * D_MODEL / 3 / 128)) * 128
CONV_W = 3

N_MLSTM_LAYERS = (DEPTH + 1) // 2
N_ATTN_LAYERS = DEPTH // 2

kernel_name = "hybrid_mlstm_swa_sink_convffn"


def rmsnorm(x, g):
    xf = x.astype(jnp.float32)
    y = xf * lax.rsqrt(jnp.mean(xf * xf, axis=-1, keepdims=True) + EPS)
    return (y * g.astype(jnp.float32)).astype(x.dtype)


def softcap(z, cap):
    return cap * jnp.tanh(z / cap)


def mlstm_mixer(h, w_in, gate_bias, head_norm, w_out):
    B, S, _ = h.shape
    H, dk, dv, L = M_HEADS, M_QK_DIM, M_V_DIM, M_CHUNK
    NC = S // L
    proj = h @ w_in
    splits = np.cumsum([H * dk, H * dk, H * dv, D_MODEL, H])
    q, k, v, o, ig_raw, fg_raw = jnp.split(proj, splits.tolist(), axis=-1)
    ig = softcap(ig_raw.astype(jnp.float32) + gate_bias[0].astype(jnp.float32), GATE_CAP)
    lf = jax.nn.log_sigmoid(softcap(fg_raw.astype(jnp.float32) + gate_bias[1].astype(jnp.float32), GATE_CAP))

    def to_chunks(t, d):
        return t.astype(jnp.float32).reshape(B, NC, L, H, d).transpose(1, 0, 3, 2, 4)

    def gate_chunks(t):
        return t.reshape(B, NC, L, H).transpose(1, 0, 3, 2)

    qc = to_chunks(q, dk) * (dk ** -0.5)
    kc = to_chunks(k, dk)
    vc = to_chunks(v, dv)
    igc, lfc = gate_chunks(ig), gate_chunks(lf)
    causal = jnp.tril(jnp.ones((L, L), dtype=bool))

    def body(carry, xs):
        C, n, m = carry
        qb, kb, vb, igb, lfb = xs
        b = jnp.cumsum(lfb, axis=-1)
        inter = b + m[..., None]
        dlog = b[..., :, None] - b[..., None, :] + igb[..., None, :]
        dlog = jnp.where(causal, dlog, -jnp.inf)
        m_t = jnp.maximum(inter, jnp.max(dlog, axis=-1))
        w = jnp.einsum('bhtd,bhsd->bhts', qb, kb) * jnp.exp(dlog - m_t[..., None])
        s_inter = jnp.exp(inter - m_t)
        num = jnp.einsum('bhts,bhsv->bhtv', w, vb) + s_inter[..., None] * jnp.einsum('bhtd,bhdv->bhtv', qb, C)
        den = jnp.sum(w, axis=-1) + s_inter * jnp.einsum('bhtd,bhd->bht', qb, n)
        hout = num / jnp.maximum(jnp.abs(den), jnp.exp(-m_t))[..., None]
        bL = b[..., -1]
        tail = bL[..., None] - b + igb
        m_new = jnp.maximum(bL + m, jnp.max(tail, axis=-1))
        ws = jnp.exp(tail - m_new[..., None])
        decay = jnp.exp(bL + m - m_new)
        C_new = decay[..., None, None] * C + jnp.einsum('bhs,bhsd,bhsv->bhdv', ws, kb, vb)
        n_new = decay[..., None] * n + jnp.einsum('bhs,bhsd->bhd', ws, kb)
        return (C_new, n_new, m_new), hout

    init = (jnp.zeros((B, H, dk, dv), jnp.float32),
            jnp.zeros((B, H, dk), jnp.float32),
            jnp.zeros((B, H), jnp.float32))
    _, hs = lax.scan(body, init, (qc, kc, vc, igc, lfc))
    hs = hs.transpose(1, 0, 3, 2, 4).reshape(B, S, H, dv)
    hs = hs * lax.rsqrt(jnp.mean(hs * hs, axis=-1, keepdims=True) + EPS)
    hs = hs * head_norm.astype(jnp.float32).reshape(H, dv)
    gated = jax.nn.sigmoid(o.astype(jnp.float32)) * hs.reshape(B, S, H * dv)
    return gated.astype(h.dtype) @ w_out


def swa_sink_mixer(h, w_in, b_in, sinks, w_out, b_out):
    B, S, _ = h.shape
    Hq, Hkv, G, dh, BLK = A_Q_HEADS, A_KV_HEADS, A_GROUP, A_HEAD_DIM, A_BLOCK
    NB = S // BLK
    proj = h @ w_in + b_in
    q, k, v = jnp.split(proj, [Hq * dh, (Hq + Hkv) * dh], axis=-1)
    q = q.reshape(B, NB, BLK, Hkv, G, dh) * (dh ** -0.5)
    k = k.reshape(B, NB, BLK, Hkv, dh)
    v = v.reshape(B, NB, BLK, Hkv, dh)

    def with_prev(t):
        prev = jnp.pad(t, ((0, 0), (1, 0), (0, 0), (0, 0), (0, 0)))[:, :-1]
        return jnp.concatenate([prev, t], axis=2)

    kc, vc = with_prev(k), with_prev(v)
    s = jnp.einsum('bnqhgd,bnkhd->bnhgqk', q, kc).astype(jnp.float32)
    qi = jnp.arange(BLK)[:, None]
    ku = jnp.arange(2 * BLK)[None, :]
    diff = qi - (ku - BLK)
    band = (diff >= 0) & (diff < WINDOW)
    kpos = jnp.arange(NB)[:, None, None] * BLK + ku[None] - BLK
    mask = band[None] & (kpos >= 0)
    s = jnp.where(mask[None, :, None, None], s, -jnp.inf)
    sink = sinks.astype(jnp.float32).reshape(1, 1, Hkv, G, 1, 1)
    mx = jnp.maximum(jnp.max(s, axis=-1, keepdims=True), sink)
    p = jnp.exp(s - mx)
    p = p / (jnp.sum(p, axis=-1, keepdims=True) + jnp.exp(sink - mx))
    o = jnp.einsum('bnhgqk,bnkhd->bnqhgd', p.astype(vc.dtype), vc).reshape(B, S, Hq * dh)
    return o @ w_out + b_out


def conv_ffn(h, w_up, conv_w, conv_b, w_down):
    S = h.shape[1]
    u = h @ w_up
    gate, val = jnp.split(u, 2, axis=-1)
    gp = jnp.pad(gate, ((0, 0), (CONV_W - 1, 0), (0, 0)))
    gate_c = conv_b + sum(conv_w[j] * gp[:, j:j + S] for j in range(CONV_W))
    return (jax.nn.silu(gate_c) * val) @ w_down


def setup_inputs(seed: int = 0) -> dict:
    key = jax.random.key(seed)
    ks = jax.random.split(key, 24)
    nrm = lambda k, shape, s: jax.random.normal(k, shape, jnp.float32) * s
    LM, LA = N_MLSTM_LAYERS, N_ATTN_LAYERS
    f_bias = jnp.broadcast_to(jnp.linspace(3.0, 6.0, M_HEADS), (LM, M_HEADS)) + nrm(ks[2], (LM, M_HEADS), 0.1)
    i_bias = nrm(ks[3], (LM, M_HEADS), 0.1)
    gain = lambda k: 1.0 + nrm(k, (DEPTH, D_MODEL), 0.02)
    return {
        "x": nrm(ks[0], (BATCH, SEQ, D_MODEL), 1.0),
        "m_w_in": nrm(ks[1], (LM, D_MODEL, M_IN), D_MODEL ** -0.5),
        "m_gate_bias": jnp.stack([i_bias, f_bias], axis=1),
        "m_head_norm": 1.0 + nrm(ks[4], (LM, M_HEADS * M_V_DIM), 0.02),
        "m_w_out": nrm(ks[5], (LM, M_HEADS * M_V_DIM, D_MODEL), (M_HEADS * M_V_DIM) ** -0.5),
        "a_w_in": nrm(ks[6], (LA, D_MODEL, A_IN), D_MODEL ** -0.5),
        "a_b_in": nrm(ks[7], (LA, A_IN), 0.02),
        "a_sinks": nrm(ks[8], (LA, A_Q_HEADS), 0.5),
        "a_w_out": nrm(ks[9], (LA, A_Q_HEADS * A_HEAD_DIM, D_MODEL), (A_Q_HEADS * A_HEAD_DIM) ** -0.5),
        "a_b_out": nrm(ks[10], (LA, D_MODEL), 0.02),
        "norm_mix_pre": gain(ks[11]),
        "norm_mix_post": gain(ks[12]),
        "norm_ffn_pre": gain(ks[13]),
        "norm_ffn_post": gain(ks[14]),
        "f_w_up": nrm(ks[15], (DEPTH, D_MODEL, 2 * D_FF), D_MODEL ** -0.5),
        "f_conv_w": nrm(ks[16], (DEPTH, CONV_W, D_FF), CONV_W ** -0.5),
        "f_conv_b": nrm(ks[17], (DEPTH, D_FF), 0.02),
        "f_w_down": nrm(ks[18], (DEPTH, D_FF, D_MODEL), D_FF ** -0.5),
    }


def reference(x, m_w_in, m_gate_bias, m_head_norm, m_w_out,
              a_w_in, a_b_in, a_sinks, a_w_out, a_b_out,
              norm_mix_pre, norm_mix_post, norm_ffn_pre, norm_ffn_post,
              f_w_up, f_conv_w, f_conv_b, f_w_down):
    h = x
    for i in range(DEPTH):
        z = rmsnorm(h, norm_mix_pre[i])
        if i % N_MIXERS == 0:
            j = i // N_MIXERS
            z = mlstm_mixer(z, m_w_in[j], m_gate_bias[j], m_head_norm[j], m_w_out[j])
        else:
            j = i // N_MIXERS
            z = swa_sink_mixer(z, a_w_in[j], a_b_in[j], a_sinks[j], a_w_out[j], a_b_out[j])
        h = h + rmsnorm(z, norm_mix_post[i])
        z = conv_ffn(rmsnorm(h, norm_ffn_pre[i]), f_w_up[i], f_conv_w[i], f_conv_b[i], f_w_down[i])
        h = h + rmsnorm(z, norm_ffn_post[i])
    return h
```

```cpp
#include <hip/hip_runtime.h>
#include <cstdio>
#include <cstdint>

#define LAS __attribute__((address_space(3)))
typedef unsigned short bf16;
typedef short bf16x8 __attribute__((ext_vector_type(8)));
typedef float f32x4 __attribute__((ext_vector_type(4)));
typedef float f32x2 __attribute__((ext_vector_type(2)));
typedef unsigned u32x4 __attribute__((ext_vector_type(4)));
typedef unsigned u32x2 __attribute__((ext_vector_type(2)));
typedef __bf16 bf16x2_t __attribute__((ext_vector_type(2)));

constexpr int SEQ = 8192, DM = 1024, M = 16384;
constexpr int MIN_N = 3072, MIN_TOT = 3088;
constexpr int QOFF = 0, KOFF = 512, VOFF = 1024, OOFF = 2048;
constexpr int AIN_N = 1280;
constexpr int DFF = 2816, UP_N = 5632;
constexpr float EPS = 1e-6f, GCAP = 15.0f;
constexpr int NUNIT = 2048;

constexpr size_t MiB = 1u << 20;
constexpr size_t WS_CTL = 0;
constexpr size_t WS_WMIN = 1 * MiB, WS_WMOUT = 7 * MiB, WS_WAIN = 9 * MiB, WS_WAOUT = 12 * MiB;
constexpr size_t WS_WUP0 = 14 * MiB, WS_WUP1 = 25 * MiB, WS_WDN0 = 36 * MiB, WS_WDN1 = 42 * MiB;
constexpr size_t WS_IG = 48 * MiB, WS_LF = WS_IG + 512 * 1024, WS_DN = 49 * MiB, WS_NS = WS_DN + 512 * 1024;
constexpr size_t WS_BL = 50 * MiB, WS_AMX = WS_BL + 8192, WS_MS = WS_AMX + 8192;
constexpr size_t WS_XN = 52 * MiB;
constexpr size_t WS_R = 84 * MiB;
constexpr size_t WS_QKVO = WS_R, WS_DC = 180 * MiB, WS_G = 180 * MiB, WS_CS = 212 * MiB;
constexpr size_t WS_GT = WS_R, WS_ACT = 128 * MiB, WS_Z = 172 * MiB;
constexpr size_t WS_AQKV = WS_R, WS_AO = 124 * MiB;
constexpr size_t WS_END = 256 * MiB;

constexpr int LDS_BYTES = 163840;

__device__ __forceinline__ unsigned pk2(float lo, float hi) { f32x2 v = {lo, hi}; bf16x2_t b = __builtin_convertvector(v, bf16x2_t); return __builtin_bit_cast(unsigned, b); }
__device__ __forceinline__ bf16 f2bf(float f) { return (bf16)(pk2(f, 0.f) & 0xffffu); }
__device__ __forceinline__ float bf2f(bf16 h) { return __uint_as_float(((unsigned)h) << 16); }
__device__ __forceinline__ float wave_sum(float v) {
#pragma unroll
    for (int o = 1; o < 64; o <<= 1) v += __shfl_xor(v, o);
    return v;
}
__device__ __forceinline__ float softcap(float z) { return GCAP * tanhf(z * (1.0f / GCAP)); }
__device__ __forceinline__ float logsig(float x) { return fminf(x, 0.f) - log1pf(expf(-fabsf(x))); }

struct Args {
    const float* in[18]; float* out; unsigned char* ws;
    int phase, layer, half, pad;
};

struct Frame {
    LAS unsigned char* lds;
    int tid, lane, wave, G;
    const float* in[18]; float* out; unsigned char* ws;
};

struct Unit { int pm, pn; };
__device__ __forceinline__ int perm32(int rho) { const int n = rho >> 4, i = rho & 15; return 8 * (i >> 2) + 4 * n + (i & 3); }

template <class Epi>
__device__ __forceinline__ void gemm_simple(Frame& F, const bf16* A, const bf16* Bt, int nM, int nN, int K, const Epi& E) {
    constexpr int PITCH = 72;
    LAS bf16* As = (LAS bf16*)F.lds; LAS bf16* Bs = As + 256 * PITCH;
    const int tid = F.tid, wid = F.wave, lane = F.lane, wr = wid >> 2, wc = wid & 3, fr = lane & 15, fq = lane >> 4;
    for (int u = blockIdx.x; u < nM * nN; u += gridDim.x) {
        Unit un; un.pm = u / nN; un.pn = u % nN;
        f32x4 acc[2][2][4][2];
#pragma unroll
        for (int a = 0; a < 2; ++a)
#pragma unroll
            for (int b = 0; b < 2; ++b)
#pragma unroll
                for (int m = 0; m < 4; ++m)
#pragma unroll
                    for (int n = 0; n < 2; ++n) acc[a][b][m][n] = (f32x4){0.f, 0.f, 0.f, 0.f};
        for (int k0 = 0; k0 < K; k0 += 64) {
#pragma unroll
            for (int i = 0; i < 4; ++i) {
                const int ch = tid + i * 512, row = ch >> 3, c8 = ch & 7;
                const u32x4 va = *(const u32x4*)(A + (size_t)(un.pm * 256 + row) * K + k0 + c8 * 8);
                const u32x4 vb = *(const u32x4*)(Bt + (size_t)(un.pn * 256 + row) * K + k0 + c8 * 8);
                *(LAS u32x4*)(As + row * PITCH + c8 * 8) = va;
                *(LAS u32x4*)(Bs + row * PITCH + c8 * 8) = vb;
            }
            __syncthreads();
#pragma unroll
            for (int kk = 0; kk < 2; ++kk) {
                bf16x8 af[2][4], bfr[2][2];
#pragma unroll
                for (int ai = 0; ai < 2; ++ai)
#pragma unroll
                    for (int m = 0; m < 4; ++m) af[ai][m] = *(const LAS bf16x8*)(As + (128 * ai + 64 * wr + 16 * m + fr) * PITCH + kk * 32 + fq * 8);
#pragma unroll
                for (int bj = 0; bj < 2; ++bj)
#pragma unroll
                    for (int n = 0; n < 2; ++n) { const int slot = 16 * n + fr, col = Epi::PERM ? perm32(slot) : slot;
                        bfr[bj][n] = *(const LAS bf16x8*)(Bs + (128 * bj + 32 * wc + col) * PITCH + kk * 32 + fq * 8); }
#pragma unroll
                for (int ai = 0; ai < 2; ++ai)
#pragma unroll
                    for (int bj = 0; bj < 2; ++bj)
#pragma unroll
                        for (int m = 0; m < 4; ++m)
#pragma unroll
                            for (int n = 0; n < 2; ++n)
                                acc[ai][bj][m][n] = __builtin_amdgcn_mfma_f32_16x16x32_bf16(bfr[bj][n], af[ai][m], acc[ai][bj][m][n], 0, 0, 0);
            }
            __syncthreads();
        }
        E(acc, un, wr, wc, fr, fq);
    }
}

struct EpiBf16 {
    static constexpr bool PERM = true;
    bf16* O; int ldc; const float* bias; int scale_cols; float scale;
    __device__ __forceinline__ void operator()(const f32x4 (&acc)[2][2][4][2], const Unit& u, int wr, int wc, int fr, int fq) const {
        const int row0 = u.pm * 256 + wr * 64 + fr, col0 = u.pn * 256 + wc * 32 + 8 * fq;
#pragma unroll
        for (int ai = 0; ai < 2; ++ai)
#pragma unroll
            for (int m = 0; m < 4; ++m) { bf16* rowp = O + (size_t)(row0 + ai * 128 + m * 16) * ldc + col0;
#pragma unroll
                for (int bj = 0; bj < 2; ++bj) {
                    f32x4 v0 = acc[ai][bj][m][0], v1 = acc[ai][bj][m][1];
                    const int c = col0 + bj * 128;
                    if (bias) { v0 = v0 + *(const f32x4*)(bias + c); v1 = v1 + *(const f32x4*)(bias + c + 4); }
                    const float sc = (c < scale_cols) ? scale : 1.f; v0 = v0 * sc; v1 = v1 * sc;
                    u32x4 w; w.x = pk2(v0[0], v0[1]); w.y = pk2(v0[2], v0[3]); w.z = pk2(v1[0], v1[1]); w.w = pk2(v1[2], v1[3]);
                    *(u32x4*)(rowp + bj * 128) = w; } }
    }
};
struct EpiF32 {
    static constexpr bool PERM = false;
    float* Z; int ldc;
    __device__ __forceinline__ void operator()(const f32x4 (&acc)[2][2][4][2], const Unit& u, int wr, int wc, int fr, int fq) const {
        const int row0 = u.pm * 256 + wr * 64 + fr, col0 = u.pn * 256 + wc * 32 + 4 * fq;
#pragma unroll
        for (int ai = 0; ai < 2; ++ai)
#pragma unroll
            for (int m = 0; m < 4; ++m)
#pragma unroll
                for (int bj = 0; bj < 2; ++bj)
#pragma unroll
                    for (int n = 0; n < 2; ++n)
                        *(f32x4*)(Z + (size_t)(row0 + ai * 128 + m * 16) * ldc + col0 + bj * 128 + n * 16) = acc[ai][bj][m][n];
    }
};
struct EpiConv {
    static constexpr bool PERM = true;
    const bf16* Gt; bf16* ACT; const float* cw; const float* cb;
    __device__ __forceinline__ void operator()(const f32x4 (&acc)[2][2][4][2], const Unit& u, int wr, int wc, int fr, int fq) const {
        const int row0 = u.pm * 256 + wr * 64 + fr, col0 = u.pn * 256 + wc * 32 + 8 * fq;
#pragma unroll
        for (int ai = 0; ai < 2; ++ai)
#pragma unroll
            for (int m = 0; m < 4; ++m) { const int t = row0 + ai * 128 + m * 16;
#pragma unroll
                for (int bj = 0; bj < 2; ++bj) { const int c = col0 + bj * 128;
                    const u32x4 z4 = {0u, 0u, 0u, 0u};
                    const u32x4 g0 = *(const u32x4*)(Gt + (size_t)t * DFF + c);
                    const u32x4 g1 = (t >= 1) ? *(const u32x4*)(Gt + (size_t)(t - 1) * DFF + c) : z4;
                    const u32x4 g2 = (t >= 2) ? *(const u32x4*)(Gt + (size_t)(t - 2) * DFF + c) : z4;
                    float o[8];
#pragma unroll
                    for (int e = 0; e < 8; ++e) {
                        const unsigned w0 = g0[e >> 1], w1 = g1[e >> 1], w2 = g2[e >> 1];
                        const float a0 = (e & 1) ? __uint_as_float(w0 & 0xffff0000u) : __uint_as_float(w0 << 16);
                        const float a1 = (e & 1) ? __uint_as_float(w1 & 0xffff0000u) : __uint_as_float(w1 << 16);
                        const float a2 = (e & 1) ? __uint_as_float(w2 & 0xffff0000u) : __uint_as_float(w2 << 16);
                        const float gc = cb[c + e] + cw[c + e] * a2 + cw[DFF + c + e] * a1 + cw[2 * DFF + c + e] * a0;
                        const float v = acc[ai][bj][m][e >> 2][e & 3];
                        o[e] = gc / (1.f + __expf(-gc)) * v;
                    }
                    u32x4 w; w.x = pk2(o[0], o[1]); w.y = pk2(o[2], o[3]); w.z = pk2(o[4], o[5]); w.w = pk2(o[6], o[7]);
                    *(u32x4*)(ACT + (size_t)t * DFF + c) = w; } }
    }
};

__device__ __forceinline__ void transpose_item(const float* W, int ldw, int srcc, int K, int kb, bf16* WT, int drow, const float* gain, float scale, LAS float* scr, int lane) {
    const int k0 = 64 * kb;
#pragma unroll 8
    for (int i = 0; i < 32; ++i) { const int kk = 2 * i + (lane >> 5); float v = W[(size_t)(k0 + kk) * ldw + srcc + (lane & 31)];
        if (gain) v *= gain[k0 + kk];
        scr[kk * 33 + (lane & 31)] = v * scale; }
    asm volatile("s_waitcnt lgkmcnt(0)" ::: "memory");
    const int c = lane & 7;
#pragma unroll
    for (int j = 0; j < 4; ++j) { const int n = (lane >> 3) + 8 * j; const LAS float* s = scr + (8 * c) * 33 + n;
        u32x4 o; o.x = pk2(s[0 * 33], s[1 * 33]); o.y = pk2(s[2 * 33], s[3 * 33]); o.z = pk2(s[4 * 33], s[5 * 33]); o.w = pk2(s[6 * 33], s[7 * 33]);
        *(u32x4*)(WT + (size_t)(drow + n) * K + k0 + 8 * c) = o; }
    asm volatile("s_waitcnt lgkmcnt(0)" ::: "memory");
}
__device__ __forceinline__ void conv_job(const float* W, int ldw, int K, int N, bf16* WT, const float* gain, int qcols, LAS float* scr, int gw, int NGW, int lane) {
    const int nblk = N / 32, nit = (K / 64) * nblk;
    for (int it = gw; it < nit; it += NGW) { const int kb = it / nblk, nb = it % nblk;
        transpose_item(W, ldw, nb * 32, K, kb, WT, nb * 32, gain, (nb * 32 < qcols) ? 0.125f : 1.0f, scr, lane); }
}
__device__ __forceinline__ void p0_prologue(Frame& F) {
    LAS float* scr = (LAS float*)(F.lds + F.wave * 16384);
    const int gw = blockIdx.x * 8 + F.wave, NGW = gridDim.x * 8;
    unsigned char* ws = F.ws;
    const float* nmp = F.in[10]; const float* nfp = F.in[12];
    conv_job(F.in[1], MIN_TOT, DM, MIN_N, (bf16*)(ws + WS_WMIN), nmp, 512, scr, gw, NGW, F.lane);
    conv_job(F.in[4], DM, DM, DM, (bf16*)(ws + WS_WMOUT), nullptr, 0, scr, gw, NGW, F.lane);
    conv_job(F.in[5], AIN_N, DM, AIN_N, (bf16*)(ws + WS_WAIN), nmp + DM, 0, scr, gw, NGW, F.lane);
    conv_job(F.in[8], DM, DM, DM, (bf16*)(ws + WS_WAOUT), nullptr, 0, scr, gw, NGW, F.lane);
    conv_job(F.in[14], UP_N, DM, UP_N, (bf16*)(ws + WS_WUP0), nfp, 0, scr, gw, NGW, F.lane);
    conv_job(F.in[14] + (size_t)DM * UP_N, UP_N, DM, UP_N, (bf16*)(ws + WS_WUP1), nfp + DM, 0, scr, gw, NGW, F.lane);
    conv_job(F.in[17], DM, DFF, DM, (bf16*)(ws + WS_WDN0), nullptr, 0, scr, gw, NGW, F.lane);
    conv_job(F.in[17] + (size_t)DFF * DM, DM, DFF, DM, (bf16*)(ws + WS_WDN1), nullptr, 0, scr, gw, NGW, F.lane);
    const float* x = F.in[0]; bf16* XN = (bf16*)(ws + WS_XN);
    const float* win = F.in[1]; const float* gb = F.in[2];
    float* IG = (float*)(ws + WS_IG); float* LF = (float*)(ws + WS_LF);
    for (int m = gw; m < M; m += NGW) {
        const f32x4* xr = (const f32x4*)(x + (size_t)m * DM) + F.lane;
        f32x4 v[4]; float ss = 0.f;
#pragma unroll
        for (int j = 0; j < 4; ++j) { v[j] = xr[64 * j]; ss += (v[j].x * v[j].x + v[j].y * v[j].y) + (v[j].z * v[j].z + v[j].w * v[j].w); }
        const float rstd = 1.0f / sqrtf(wave_sum(ss) * (1.0f / DM) + EPS);
        unsigned long long* o8 = (unsigned long long*)(XN + (size_t)m * DM) + F.lane;
#pragma unroll
        for (int j = 0; j < 4; ++j) o8[64 * j] = (unsigned long long)pk2(v[j].x * rstd, v[j].y * rstd) | ((unsigned long long)pk2(v[j].z * rstd, v[j].w * rstd) << 32);
        float ga[16];
#pragma unroll
        for (int i = 0; i < 16; ++i) ga[i] = 0.f;
#pragma unroll
        for (int j = 0; j < 4; ++j)
#pragma unroll
            for (int e = 0; e < 4; ++e) { const int k = 4 * F.lane + 256 * j + e; const float xg = v[j][e] * nmp[k];
                const f32x4* wg = (const f32x4*)(win + (size_t)k * MIN_TOT + MIN_N);
#pragma unroll
                for (int q = 0; q < 4; ++q) { const f32x4 w = wg[q]; ga[4 * q] += xg * w.x; ga[4 * q + 1] += xg * w.y; ga[4 * q + 2] += xg * w.z; ga[4 * q + 3] += xg * w.w; } }
#pragma unroll
        for (int i = 0; i < 16; ++i) ga[i] = wave_sum(ga[i]) * rstd;
        if (F.lane == 0) { const int b = m >> 13, t = m & (SEQ - 1);
#pragma unroll
            for (int h = 0; h < 8; ++h) {
                IG[(size_t)(b * 8 + h) * SEQ + t] = softcap(ga[h] + gb[h]);
                LF[(size_t)(b * 8 + h) * SEQ + t] = logsig(softcap(ga[8 + h] + gb[8 + h])); } }
    }
}

__device__ __forceinline__ void mlstm_p2_simple(Frame& F) {
    LAS float* Ks = (LAS float*)F.lds;
    LAS float* Vs = Ks + 64 * 65;
    LAS float* gl = Vs + 64 * 129; LAS float* gi = gl + 64; LAS float* aa = gi + 64; LAS float* wsv = aa + 64; LAS float* sc = wsv + 64;
    const bf16* QKVO = (const bf16*)(F.ws + WS_QKVO); bf16* DC = (bf16*)(F.ws + WS_DC);
    const float* IG = (const float*)(F.ws + WS_IG); const float* LF = (const float*)(F.ws + WS_LF);
    float* DN = (float*)(F.ws + WS_DN); float* BL = (float*)(F.ws + WS_BL); float* AMX = (float*)(F.ws + WS_AMX);
    const int tid = F.tid;
    for (int u = blockIdx.x; u < NUNIT; u += gridDim.x) {
        const int bh = u >> 7, c = u & 127, b = bh >> 3, h = bh & 7; const size_t row0 = (size_t)b * SEQ + c * 64;
        if (tid < 64) { gl[tid] = LF[(size_t)bh * SEQ + c * 64 + tid]; gi[tid] = IG[(size_t)bh * SEQ + c * 64 + tid]; }
        __syncthreads();
        if (tid == 0) { float s = 0.f, amax = -INFINITY; for (int t = 0; t < 64; ++t) { s += gl[t]; const float a = gi[t] - s; aa[t] = a; amax = fmaxf(amax, a); } sc[0] = amax; sc[1] = s; }
        __syncthreads();
        if (tid < 64) wsv[tid] = expf(aa[tid] - sc[0]);
        __syncthreads();
#pragma unroll 1
        for (int i = tid; i < 64 * 64; i += 512) { const int s = i >> 6, d = i & 63; Ks[s * 65 + d] = wsv[s] * bf2f(QKVO[(row0 + s) * MIN_N + KOFF + h * 64 + d]); }
#pragma unroll 1
        for (int i = tid; i < 64 * 128; i += 512) { const int s = i >> 7, d = i & 127; Vs[s * 129 + d] = bf2f(QKVO[(row0 + s) * MIN_N + VOFF + h * 128 + d]); }
        __syncthreads();
#pragma unroll 1
        for (int j = 0; j < 16; ++j) { const int e = tid + j * 512, dv = e >> 6, dk = e & 63; float a = 0.f;
            for (int s = 0; s < 64; ++s) a += Ks[s * 65 + dk] * Vs[s * 129 + dv];
            DC[(size_t)u * 8192 + e] = f2bf(a); }
        if (tid < 64) { float a = 0.f; for (int s = 0; s < 64; ++s) a += Ks[s * 65 + tid]; DN[(size_t)u * 64 + tid] = a; }
        if (tid == 0) { BL[u] = sc[1]; AMX[u] = sc[0]; }
        __syncthreads();
    }
}
__device__ __forceinline__ void mlstm_p3_scan(Frame& F) {
    const bf16* DC = (const bf16*)(F.ws + WS_DC); bf16* CS = (bf16*)(F.ws + WS_CS);
    const float* DN = (const float*)(F.ws + WS_DN); float* NS = (float*)(F.ws + WS_NS);
    const float* BL = (const float*)(F.ws + WS_BL); const float* AMX = (const float*)(F.ws + WS_AMX); float* MS = (float*)(F.ws + WS_MS);
    for (int w = blockIdx.x; w < 256; w += gridDim.x) {
        const int bh = w >> 4, sl = w & 15, e = sl * 512 + F.tid; const bool nth = (sl == 0 && F.tid < 64);
        float C = 0.f, n = 0.f, m = 0.f;
#pragma unroll 8
        for (int c = 0; c < 128; ++c) { const int u = bh * 128 + c;
            const float bl = BL[u], am = AMX[u];
            CS[(size_t)u * 8192 + e] = f2bf(C);
            if (nth) NS[(size_t)u * 64 + F.tid] = n;
            if (sl == 0 && F.tid == 0) MS[u] = m;
            const float mt = bl + am, mn = fmaxf(bl + m, mt), dec = expf(bl + m - mn), scl = expf(mt - mn);
            C = dec * C + scl * bf2f(DC[(size_t)u * 8192 + e]);
            if (nth) n = dec * n + scl * DN[(size_t)u * 64 + F.tid];
            m = mn; }
    }
}
__device__ __forceinline__ void mlstm_p4_simple(Frame& F) {
    LAS float* Qs = (LAS float*)F.lds;
    LAS float* Ks = Qs + 64 * 65;
    LAS float* Vs = Ks + 64 * 65;
    LAS float* Cs = Vs + 64 * 129;
    LAS float* Ws = Cs + 128 * 65;
    LAS float* Hs = Ws + 64 * 65;
    LAS float* gl = Hs + 64 * 129; LAS float* gi = gl + 64; LAS float* aa = gi + 64; LAS float* bb = aa + 64; LAS float* Mt = bb + 64;
    LAS float* sint = Mt + 64; LAS float* eneg = sint + 64; LAS float* dinv = eneg + 64; LAS float* rs = dinv + 64; LAS float* nv = rs + 64;
    const bf16* QKVO = (const bf16*)(F.ws + WS_QKVO); const bf16* CS = (const bf16*)(F.ws + WS_CS); bf16* G = (bf16*)(F.ws + WS_G);
    const float* IG = (const float*)(F.ws + WS_IG); const float* LF = (const float*)(F.ws + WS_LF);
    const float* NS = (const float*)(F.ws + WS_NS); const float* MS = (const float*)(F.ws + WS_MS);
    const float* hnorm = F.in[3];
    const int tid = F.tid;
    for (int u = blockIdx.x; u < NUNIT; u += gridDim.x) {
        const int bh = u >> 7, c = u & 127, b = bh >> 3, h = bh & 7; const size_t row0 = (size_t)b * SEQ + c * 64;
        const float mc = MS[u];
        if (tid < 64) { gl[tid] = LF[(size_t)bh * SEQ + c * 64 + tid]; gi[tid] = IG[(size_t)bh * SEQ + c * 64 + tid]; nv[tid] = NS[(size_t)u * 64 + tid]; }
        __syncthreads();
        if (tid == 0) { float s = 0.f, cm = mc; for (int t = 0; t < 64; ++t) { s += gl[t]; bb[t] = s; const float a = gi[t] - s; aa[t] = a; cm = fmaxf(cm, a); Mt[t] = cm; } }
        __syncthreads();
        if (tid < 64) { sint[tid] = expf(mc - Mt[tid]); eneg[tid] = expf(-bb[tid] - Mt[tid]); }
#pragma unroll 1
        for (int i = tid; i < 64 * 64; i += 512) { const int s = i >> 6, d = i & 63;
            Qs[s * 65 + d] = bf2f(QKVO[(row0 + s) * MIN_N + QOFF + h * 64 + d]); Ks[s * 65 + d] = bf2f(QKVO[(row0 + s) * MIN_N + KOFF + h * 64 + d]); }
#pragma unroll 1
        for (int i = tid; i < 64 * 128; i += 512) { const int s = i >> 7, d = i & 127; Vs[s * 129 + d] = bf2f(QKVO[(row0 + s) * MIN_N + VOFF + h * 128 + d]); }
#pragma unroll 1
        for (int i = tid; i < 128 * 64; i += 512) { const int dv = i >> 6, dk = i & 63; Cs[dv * 65 + dk] = bf2f(CS[(size_t)u * 8192 + i]); }
        __syncthreads();
#pragma unroll 1
        for (int j = 0; j < 8; ++j) { const int i = tid + j * 512, t = i >> 6, s = i & 63; float w = 0.f;
            if (s <= t) { float d = 0.f; for (int k = 0; k < 64; ++k) d += Qs[t * 65 + k] * Ks[s * 65 + k]; w = d * expf(aa[s] - Mt[t]); }
            Ws[t * 65 + s] = w; }
        __syncthreads();
        if (tid < 64) { const int t = tid; float den = 0.f, qn = 0.f; for (int s = 0; s < 64; ++s) den += Ws[t * 65 + s];
            for (int k = 0; k < 64; ++k) qn += Qs[t * 65 + k] * nv[k];
            den += sint[t] * qn; dinv[t] = 1.0f / fmaxf(fabsf(den), eneg[t]); }
        __syncthreads();
#pragma unroll 1
        for (int j = 0; j < 16; ++j) { const int i = tid + j * 512, t = i >> 7, dv = i & 127; float a = 0.f, ci = 0.f;
            for (int s = 0; s < 64; ++s) a += Ws[t * 65 + s] * Vs[s * 129 + dv];
            for (int k = 0; k < 64; ++k) ci += Qs[t * 65 + k] * Cs[dv * 65 + k];
            Hs[t * 129 + dv] = (a + sint[t] * ci) * dinv[t]; }
        __syncthreads();
        if (tid < 64) { float ss = 0.f; for (int d = 0; d < 128; ++d) { const float v = Hs[tid * 129 + d]; ss += v * v; } rs[tid] = 1.0f / sqrtf(ss * (1.0f / 128.f) + EPS); }
        __syncthreads();
#pragma unroll 1
        for (int j = 0; j < 16; ++j) { const int i = tid + j * 512, t = i >> 7, dv = i & 127;
            const float o = bf2f(QKVO[(row0 + t) * MIN_N + OOFF + h * 128 + dv]);
            const float g = Hs[t * 129 + dv] * rs[t] * hnorm[h * 128 + dv] / (1.0f + expf(-o));
            G[(row0 + t) * DM + h * 128 + dv] = f2bf(g); }
        __syncthreads();
    }
}

__device__ __forceinline__ void attn_simple(Frame& F) {
    LAS float* Qs = (LAS float*)F.lds;
    LAS float* Ks = Qs + 32 * 65;
    LAS float* Vs = Ks + 160 * 65;
    LAS float* Ss = Vs + 160 * 65;
    LAS float* pinv = Ss + 32 * 161;
    const bf16* QKV = (const bf16*)(F.ws + WS_AQKV); bf16* AO = (bf16*)(F.ws + WS_AO);
    const float* sinks = F.in[7];
    const int tid = F.tid;
    for (int u = blockIdx.x; u < 2 * 16 * 256; u += gridDim.x) {
        const int b = u >> 12, hq = (u >> 8) & 15, qb = u & 255, kvh = hq >> 3; const int q0 = qb * 32, ks0 = q0 - 128;
        const size_t rb = (size_t)b * SEQ; const float sink = sinks[hq];
#pragma unroll 1
        for (int i = tid; i < 32 * 64; i += 512) { const int t = i >> 6, d = i & 63; Qs[t * 65 + d] = bf2f(QKV[(rb + q0 + t) * AIN_N + hq * 64 + d]); }
#pragma unroll 1
        for (int i = tid; i < 160 * 64; i += 512) { const int j = i >> 6, d = i & 63, kp = ks0 + j; float kv = 0.f, vv = 0.f;
            if (kp >= 0) { kv = bf2f(QKV[(rb + kp) * AIN_N + 1024 + kvh * 64 + d]); vv = bf2f(QKV[(rb + kp) * AIN_N + 1152 + kvh * 64 + d]); }
            Ks[j * 65 + d] = kv; Vs[j * 65 + d] = vv; }
        __syncthreads();
#pragma unroll 1
        for (int jj = 0; jj < 10; ++jj) { const int i = tid + jj * 512, t = i / 160, j = i % 160; const int qp = q0 + t, kp = ks0 + j, diff = qp - kp;
            float s = -INFINITY;
            if (kp >= 0 && diff >= 0 && diff < 128) { float d = 0.f; for (int k = 0; k < 64; ++k) d += Qs[t * 65 + k] * Ks[j * 65 + k]; s = d; }
            Ss[t * 161 + j] = s; }
        __syncthreads();
        if (tid < 32) { const int t = tid; float mx = sink; for (int j = 0; j < 160; ++j) mx = fmaxf(mx, Ss[t * 161 + j]);
            float sum = expf(sink - mx); for (int j = 0; j < 160; ++j) { const float s = Ss[t * 161 + j]; const float p = (s == -INFINITY) ? 0.f : expf(s - mx); Ss[t * 161 + j] = p; sum += p; }
            pinv[t] = 1.0f / sum; }
        __syncthreads();
#pragma unroll 1
        for (int jj = 0; jj < 4; ++jj) { const int i = tid + jj * 512, t = i >> 6, d = i & 63; float a = 0.f;
            for (int j = 0; j < 160; ++j) a += Ss[t * 161 + j] * Vs[j * 65 + d];
            AO[(rb + q0 + t) * DM + hq * 64 + d] = f2bf(a * pinv[t]); }
        __syncthreads();
    }
}

__device__ __forceinline__ void norm_res_rows(Frame& F, const float* Z, const float* bias, const float* base, const float* gpost, float* out, bf16* XN) {
    const int gw = blockIdx.x * 8 + F.wave, NGW = gridDim.x * 8;
    for (int m = gw; m < M; m += NGW) {
        const f32x4* zr = (const f32x4*)(Z + (size_t)m * DM) + F.lane; const f32x4* br = (const f32x4*)(base + (size_t)m * DM) + F.lane;
        f32x4 z[4], x1[4]; float ss = 0.f;
#pragma unroll
        for (int j = 0; j < 4; ++j) { z[j] = zr[64 * j]; if (bias) z[j] = z[j] + ((const f32x4*)bias)[F.lane + 64 * j];
            ss += (z[j].x * z[j].x + z[j].y * z[j].y) + (z[j].z * z[j].z + z[j].w * z[j].w); }
        const float r1 = 1.0f / sqrtf(wave_sum(ss) * (1.0f / DM) + EPS); float s2 = 0.f;
#pragma unroll
        for (int j = 0; j < 4; ++j) { const f32x4 g = ((const f32x4*)gpost)[F.lane + 64 * j]; x1[j] = br[64 * j] + z[j] * r1 * g;
            s2 += (x1[j].x * x1[j].x + x1[j].y * x1[j].y) + (x1[j].z * x1[j].z + x1[j].w * x1[j].w); }
        f32x4* orow = (f32x4*)(out + (size_t)m * DM) + F.lane;
#pragma unroll
        for (int j = 0; j < 4; ++j) orow[64 * j] = x1[j];
        if (XN) { const float r2 = 1.0f / sqrtf(wave_sum(s2) * (1.0f / DM) + EPS);
            unsigned long long* o8 = (unsigned long long*)(XN + (size_t)m * DM) + F.lane;
#pragma unroll
            for (int j = 0; j < 4; ++j) o8[64 * j] = (unsigned long long)pk2(x1[j].x * r2, x1[j].y * r2) | ((unsigned long long)pk2(x1[j].z * r2, x1[j].w * r2) << 32); }
    }
}

enum Phase { PH_PRO = 0, PH_MIN, PH_M2, PH_M3, PH_M4, PH_MOUT, PH_NR_MIX, PH_UPG, PH_UPV, PH_DOWN, PH_NR_FFN, PH_AIN, PH_ATT, PH_AOUT };

__global__ void __launch_bounds__(512, 2) skel_fwd(Args args) {
    extern __shared__ __attribute__((aligned(16))) unsigned char lds[];
    Frame F;
    F.lds = (LAS unsigned char*)lds; F.tid = threadIdx.x; F.lane = F.tid & 63; F.wave = __builtin_amdgcn_readfirstlane(F.tid >> 6); F.G = gridDim.x;
#pragma unroll
    for (int i = 0; i < 18; ++i) F.in[i] = args.in[i];
    F.out = args.out; F.ws = args.ws;
    unsigned char* ws = args.ws;
    const int L = args.layer, hf = args.half;
    bf16* XN = (bf16*)(ws + WS_XN); float* Zb = (float*)(ws + WS_Z);
    switch (args.phase) {
    case PH_PRO: p0_prologue(F); break;
    case PH_MIN: { EpiBf16 E{(bf16*)(ws + WS_QKVO), MIN_N, nullptr, 0, 1.f}; gemm_simple(F, XN, (const bf16*)(ws + WS_WMIN), 64, 12, DM, E); } break;
    case PH_M2: mlstm_p2_simple(F); break;
    case PH_M3: mlstm_p3_scan(F); break;
    case PH_M4: mlstm_p4_simple(F); break;
    case PH_MOUT: { EpiF32 E{Zb, DM}; gemm_simple(F, (const bf16*)(ws + WS_G), (const bf16*)(ws + WS_WMOUT), 64, 4, DM, E); } break;
    case PH_NR_MIX: norm_res_rows(F, Zb, L == 0 ? nullptr : F.in[9], L == 0 ? F.in[0] : F.out, F.in[11] + L * DM, F.out, XN); break;
    case PH_UPG: { EpiBf16 E{(bf16*)(ws + WS_GT), DFF, nullptr, 0, 1.f};
        gemm_simple(F, XN + (size_t)hf * SEQ * DM, (const bf16*)(ws + (L ? WS_WUP1 : WS_WUP0)), 32, 11, DM, E); } break;
    case PH_UPV: { EpiConv E{(const bf16*)(ws + WS_GT), (bf16*)(ws + WS_ACT), F.in[15] + (size_t)L * 3 * DFF, F.in[16] + (size_t)L * DFF};
        gemm_simple(F, XN + (size_t)hf * SEQ * DM, (const bf16*)(ws + (L ? WS_WUP1 : WS_WUP0)) + (size_t)DFF * DM, 32, 11, DM, E); } break;
    case PH_DOWN: { EpiF32 E{Zb + (size_t)hf * SEQ * DM, DM}; gemm_simple(F, (const bf16*)(ws + WS_ACT), (const bf16*)(ws + (L ? WS_WDN1 : WS_WDN0)), 32, 4, DFF, E); } break;
    case PH_NR_FFN: norm_res_rows(F, Zb, nullptr, F.out, F.in[13] + L * DM, F.out, L == 0 ? XN : nullptr); break;
    case PH_AIN: { EpiBf16 E{(bf16*)(ws + WS_AQKV), AIN_N, F.in[6], 1024, 0.125f}; gemm_simple(F, XN, (const bf16*)(ws + WS_WAIN), 64, 5, DM, E); } break;
    case PH_ATT: attn_simple(F); break;
    case PH_AOUT: { EpiF32 E{Zb, DM}; gemm_simple(F, (const bf16*)(ws + WS_AO), (const bf16*)(ws + WS_WAOUT), 64, 4, DM, E); } break;
    default: break;
    }
}

extern "C" void kernel_launch(void* const* d_in, const int* in_sizes, int n_in, void* d_out, int out_size, void* d_ws, size_t ws_size, hipStream_t stream) {
    static int grid = 0;
    if (grid == 0) {
        if (n_in != 18 || in_sizes[0] != M * DM || out_size != M * DM || ws_size < WS_END) { fprintf(stderr, "kernel_launch: unexpected shapes (n_in %d, in0 %d, out %d, ws %zu)\n", n_in, n_in > 0 ? in_sizes[0] : -1, out_size, ws_size); grid = -1; return; }
        int dev = 0, cus = 0, per_cu = 0;
        hipGetDevice(&dev); hipDeviceGetAttribute(&cus, hipDeviceAttributeMultiprocessorCount, dev);
        if (hipFuncSetAttribute((const void*)skel_fwd, hipFuncAttributeMaxDynamicSharedMemorySize, LDS_BYTES) != hipSuccess) { fprintf(stderr, "kernel_launch: hipFuncSetAttribute failed\n"); grid = -1; return; }
        hipOccupancyMaxActiveBlocksPerMultiprocessor(&per_cu, (const void*)skel_fwd, 512, LDS_BYTES);
        (void)hipGetLastError();
        grid = cus > 0 ? cus : 256;
    }
    if (grid < 0) return;
    Args a{};
    for (int i = 0; i < 18; ++i) a.in[i] = (const float*)d_in[i];
    a.out = (float*)d_out; a.ws = (unsigned char*)d_ws;
    auto run = [&](int ph, int layer, int half) { a.phase = ph; a.layer = layer; a.half = half; hipLaunchKernelGGL(skel_fwd, dim3(grid), dim3(512), LDS_BYTES, stream, a); };
    run(PH_PRO, 0, 0);
    run(PH_MIN, 0, 0); run(PH_M2, 0, 0); run(PH_M3, 0, 0); run(PH_M4, 0, 0); run(PH_MOUT, 0, 0); run(PH_NR_MIX, 0, 0);
    for (int hf = 0; hf < 2; ++hf) { run(PH_UPG, 0, hf); run(PH_UPV, 0, hf); run(PH_DOWN, 0, hf); }
    run(PH_NR_FFN, 0, 0);
    run(PH_AIN, 1, 0); run(PH_ATT, 1, 0); run(PH_AOUT, 1, 0); run(PH_NR_MIX, 1, 0);
    for (int hf = 0; hf < 2; ++hf) { run(PH_UPG, 1, hf); run(PH_UPV, 1, hf); run(PH_DOWN, 1, hf); }
    run(PH_NR_FFN, 1, 0);
}
```

```cpp
#include <hip/hip_runtime.h>
#include <cstdio>
#include <cstdint>

#define LAS __attribute__((address_space(3)))
typedef unsigned short bf16;
typedef short bf16x8 __attribute__((ext_vector_type(8)));
typedef float f32x4 __attribute__((ext_vector_type(4)));
typedef float f32x2 __attribute__((ext_vector_type(2)));
typedef unsigned u32x4 __attribute__((ext_vector_type(4)));
typedef unsigned u32x2 __attribute__((ext_vector_type(2)));
typedef __bf16 bf16x2_t __attribute__((ext_vector_type(2)));

constexpr int SEQ = 8192, DM = 1024, M = 16384;
constexpr int MIN_N = 3072, MIN_TOT = 3088;
constexpr int QOFF = 0, KOFF = 512, VOFF = 1024, OOFF = 2048;
constexpr int AIN_N = 1280;
constexpr int DFF = 2816, UP_N = 5632;
constexpr float EPS = 1e-6f, GCAP = 15.0f;
constexpr int NUNIT = 2048;

constexpr size_t MiB = 1u << 20;
constexpr size_t WS_CTL = 0;
constexpr size_t WS_WMIN = 1 * MiB, WS_WMOUT = 7 * MiB, WS_WAIN = 9 * MiB, WS_WAOUT = 12 * MiB;
constexpr size_t WS_WUP0 = 14 * MiB, WS_WUP1 = 25 * MiB, WS_WDN0 = 36 * MiB, WS_WDN1 = 42 * MiB;
constexpr size_t WS_IG = 48 * MiB, WS_LF = WS_IG + 512 * 1024, WS_DN = 49 * MiB, WS_NS = WS_DN + 512 * 1024;
constexpr size_t WS_BL = 50 * MiB, WS_AMX = WS_BL + 8192, WS_MS = WS_AMX + 8192;
constexpr size_t WS_XN = 52 * MiB;
constexpr size_t WS_R = 84 * MiB;
constexpr size_t WS_QKVO = WS_R, WS_DC = 180 * MiB, WS_G = 180 * MiB, WS_CS = 212 * MiB;
constexpr size_t WS_GT = WS_R, WS_ACT = 128 * MiB, WS_Z = 172 * MiB;
constexpr size_t WS_AQKV = WS_R, WS_AO = 124 * MiB;
constexpr size_t WS_END = 256 * MiB;

constexpr int LDS_BYTES = 163840;

__device__ __forceinline__ unsigned pk2(float lo, float hi) { f32x2 v = {lo, hi}; bf16x2_t b = __builtin_convertvector(v, bf16x2_t); return __builtin_bit_cast(unsigned, b); }
__device__ __forceinline__ bf16 f2bf(float f) { return (bf16)(pk2(f, 0.f) & 0xffffu); }
__device__ __forceinline__ float bf2f(bf16 h) { return __uint_as_float(((unsigned)h) << 16); }
__device__ __forceinline__ float wave_sum(float v) {
#pragma unroll
    for (int o = 1; o < 64; o <<= 1) v += __shfl_xor(v, o);
    return v;
}
__device__ __forceinline__ float softcap(float z) { return GCAP * tanhf(z * (1.0f / GCAP)); }
__device__ __forceinline__ float logsig(float x) { return fminf(x, 0.f) - log1pf(expf(-fabsf(x))); }

struct Args {
    const float* in[18]; float* out; unsigned char* ws;
    int phase, layer, half, pad;
};

struct Frame {
    LAS unsigned char* lds;
    int tid, lane, wave, G;
    unsigned char* ws;
    __device__ __forceinline__ const float* in(int i) const {
        const unsigned long long v = ((const LAS unsigned long long*)(lds + (LDS_BYTES - 512)))[i];
        const unsigned lo = __builtin_amdgcn_readfirstlane((unsigned)v), hi = __builtin_amdgcn_readfirstlane((unsigned)(v >> 32));
        return (const float*)(((unsigned long long)hi << 32) | lo); }
    __device__ __forceinline__ float* out() const { return (float*)in(18); }
};

struct Unit { int pm, pn; };
__device__ __forceinline__ int perm32(int rho) { const int n = rho >> 4, i = rho & 15; return 8 * (i >> 2) + 4 * n + (i & 3); }

template <class Epi>
__device__ __forceinline__ void gemm_simple(Frame& F, const bf16* A, const bf16* Bt, int nM, int nN, int K, const Epi& E) {
    constexpr int PITCH = 72;
    LAS bf16* As = (LAS bf16*)F.lds; LAS bf16* Bs = As + 256 * PITCH;
    const int tid = F.tid, wid = F.wave, lane = F.lane, wr = wid >> 2, wc = wid & 3, fr = lane & 15, fq = lane >> 4;
    for (int u = blockIdx.x; u < nM * nN; u += gridDim.x) {
        Unit un; un.pm = u / nN; un.pn = u % nN;
        f32x4 acc[2][2][4][2];
#pragma unroll
        for (int a = 0; a < 2; ++a)
#pragma unroll
            for (int b = 0; b < 2; ++b)
#pragma unroll
                for (int m = 0; m < 4; ++m)
#pragma unroll
                    for (int n = 0; n < 2; ++n) acc[a][b][m][n] = (f32x4){0.f, 0.f, 0.f, 0.f};
        for (int k0 = 0; k0 < K; k0 += 64) {
#pragma unroll
            for (int i = 0; i < 4; ++i) {
                const int ch = tid + i * 512, row = ch >> 3, c8 = ch & 7;
                const u32x4 va = *(const u32x4*)(A + (size_t)(un.pm * 256 + row) * K + k0 + c8 * 8);
                const u32x4 vb = *(const u32x4*)(Bt + (size_t)(un.pn * 256 + row) * K + k0 + c8 * 8);
                *(LAS u32x4*)(As + row * PITCH + c8 * 8) = va;
                *(LAS u32x4*)(Bs + row * PITCH + c8 * 8) = vb;
            }
            __syncthreads();
#pragma unroll
            for (int kk = 0; kk < 2; ++kk) {
                bf16x8 af[2][4], bfr[2][2];
#pragma unroll
                for (int ai = 0; ai < 2; ++ai)
#pragma unroll
                    for (int m = 0; m < 4; ++m) af[ai][m] = *(const LAS bf16x8*)(As + (128 * ai + 64 * wr + 16 * m + fr) * PITCH + kk * 32 + fq * 8);
#pragma unroll
                for (int bj = 0; bj < 2; ++bj)
#pragma unroll
                    for (int n = 0; n < 2; ++n) { const int slot = 16 * n + fr, col = Epi::PERM ? perm32(slot) : slot;
                        bfr[bj][n] = *(const LAS bf16x8*)(Bs + (128 * bj + 32 * wc + col) * PITCH + kk * 32 + fq * 8); }
#pragma unroll
                for (int ai = 0; ai < 2; ++ai)
#pragma unroll
                    for (int bj = 0; bj < 2; ++bj)
#pragma unroll
                        for (int m = 0; m < 4; ++m)
#pragma unroll
                            for (int n = 0; n < 2; ++n)
                                acc[ai][bj][m][n] = __builtin_amdgcn_mfma_f32_16x16x32_bf16(bfr[bj][n], af[ai][m], acc[ai][bj][m][n], 0, 0, 0);
            }
            __syncthreads();
        }
        E(acc, un, wr, wc, fr, fq);
    }
}

struct EpiBf16 {
    static constexpr bool PERM = true;
    bf16* O; int ldc; const float* bias; int scale_cols; float scale;
    __device__ __forceinline__ void operator()(const f32x4 (&acc)[2][2][4][2], const Unit& u, int wr, int wc, int fr, int fq) const {
        const int row0 = u.pm * 256 + wr * 64 + fr, col0 = u.pn * 256 + wc * 32 + 8 * fq;
#pragma unroll
        for (int ai = 0; ai < 2; ++ai)
#pragma unroll
            for (int m = 0; m < 4; ++m) { bf16* rowp = O + (size_t)(row0 + ai * 128 + m * 16) * ldc + col0;
#pragma unroll
                for (int bj = 0; bj < 2; ++bj) {
                    f32x4 v0 = acc[ai][bj][m][0], v1 = acc[ai][bj][m][1];
                    const int c = col0 + bj * 128;
                    if (bias) { v0 = v0 + *(const f32x4*)(bias + c); v1 = v1 + *(const f32x4*)(bias + c + 4); }
                    const float sc = (c < scale_cols) ? scale : 1.f; v0 = v0 * sc; v1 = v1 * sc;
                    u32x4 w; w.x = pk2(v0[0], v0[1]); w.y = pk2(v0[2], v0[3]); w.z = pk2(v1[0], v1[1]); w.w = pk2(v1[2], v1[3]);
                    *(u32x4*)(rowp + bj * 128) = w; } }
    }
};
struct EpiF32 {
    static constexpr bool PERM = false;
    float* Z; int ldc;
    __device__ __forceinline__ void operator()(const f32x4 (&acc)[2][2][4][2], const Unit& u, int wr, int wc, int fr, int fq) const {
        const int row0 = u.pm * 256 + wr * 64 + fr, col0 = u.pn * 256 + wc * 32 + 4 * fq;
#pragma unroll
        for (int ai = 0; ai < 2; ++ai)
#pragma unroll
            for (int m = 0; m < 4; ++m)
#pragma unroll
                for (int bj = 0; bj < 2; ++bj)
#pragma unroll
                    for (int n = 0; n < 2; ++n)
                        *(f32x4*)(Z + (size_t)(row0 + ai * 128 + m * 16) * ldc + col0 + bj * 128 + n * 16) = acc[ai][bj][m][n];
    }
};
struct EpiConv {
    static constexpr bool PERM = true;
    const bf16* Gt; bf16* ACT; const float* cw; const float* cb;
    __device__ __forceinline__ void operator()(const f32x4 (&acc)[2][2][4][2], const Unit& u, int wr, int wc, int fr, int fq) const {
        const int row0 = u.pm * 256 + wr * 64 + fr, col0 = u.pn * 256 + wc * 32 + 8 * fq;
#pragma unroll
        for (int ai = 0; ai < 2; ++ai)
#pragma unroll
            for (int m = 0; m < 4; ++m) { const int t = row0 + ai * 128 + m * 16;
#pragma unroll
                for (int bj = 0; bj < 2; ++bj) { const int c = col0 + bj * 128;
                    const u32x4 z4 = {0u, 0u, 0u, 0u};
                    const u32x4 g0 = *(const u32x4*)(Gt + (size_t)t * DFF + c);
                    const u32x4 g1 = (t >= 1) ? *(const u32x4*)(Gt + (size_t)(t - 1) * DFF + c) : z4;
                    const u32x4 g2 = (t >= 2) ? *(const u32x4*)(Gt + (size_t)(t - 2) * DFF + c) : z4;
                    float o[8];
#pragma unroll
                    for (int e = 0; e < 8; ++e) {
                        const unsigned w0 = g0[e >> 1], w1 = g1[e >> 1], w2 = g2[e >> 1];
                        const float a0 = (e & 1) ? __uint_as_float(w0 & 0xffff0000u) : __uint_as_float(w0 << 16);
                        const float a1 = (e & 1) ? __uint_as_float(w1 & 0xffff0000u) : __uint_as_float(w1 << 16);
                        const float a2 = (e & 1) ? __uint_as_float(w2 & 0xffff0000u) : __uint_as_float(w2 << 16);
                        const float gc = cb[c + e] + cw[c + e] * a2 + cw[DFF + c + e] * a1 + cw[2 * DFF + c + e] * a0;
                        const float v = acc[ai][bj][m][e >> 2][e & 3];
                        o[e] = gc / (1.f + __expf(-gc)) * v;
                    }
                    u32x4 w; w.x = pk2(o[0], o[1]); w.y = pk2(o[2], o[3]); w.z = pk2(o[4], o[5]); w.w = pk2(o[6], o[7]);
                    *(u32x4*)(ACT + (size_t)t * DFF + c) = w; } }
    }
};

__device__ __forceinline__ void transpose_item(const float* W, int ldw, int srcc, int K, int kb, bf16* WT, int drow, const float* gain, float scale, LAS float* scr, int lane) {
    const int k0 = 64 * kb;
#pragma unroll 8
    for (int i = 0; i < 32; ++i) { const int kk = 2 * i + (lane >> 5); float v = W[(size_t)(k0 + kk) * ldw + srcc + (lane & 31)];
        if (gain) v *= gain[k0 + kk];
        scr[kk * 33 + (lane & 31)] = v * scale; }
    asm volatile("s_waitcnt lgkmcnt(0)" ::: "memory");
    const int c = lane & 7;
#pragma unroll
    for (int j = 0; j < 4; ++j) { const int n = (lane >> 3) + 8 * j; const LAS float* s = scr + (8 * c) * 33 + n;
        u32x4 o; o.x = pk2(s[0 * 33], s[1 * 33]); o.y = pk2(s[2 * 33], s[3 * 33]); o.z = pk2(s[4 * 33], s[5 * 33]); o.w = pk2(s[6 * 33], s[7 * 33]);
        *(u32x4*)(WT + (size_t)(drow + n) * K + k0 + 8 * c) = o; }
    asm volatile("s_waitcnt lgkmcnt(0)" ::: "memory");
}
__device__ __forceinline__ void conv_job(const float* W, int ldw, int K, int N, bf16* WT, const float* gain, int qcols, LAS float* scr, int gw, int NGW, int lane) {
    const int nblk = N / 32, nit = (K / 64) * nblk;
    for (int it = gw; it < nit; it += NGW) { const int kb = it / nblk, nb = it % nblk;
        transpose_item(W, ldw, nb * 32, K, kb, WT, nb * 32, gain, (nb * 32 < qcols) ? 0.125f : 1.0f, scr, lane); }
}
__device__ __forceinline__ void p0_prologue(Frame& F) {
    LAS float* scr = (LAS float*)(F.lds + F.wave * 16384);
    const int gw = blockIdx.x * 8 + F.wave, NGW = gridDim.x * 8;
    unsigned char* ws = F.ws;
    const float* nmp = F.in(10); const float* nfp = F.in(12);
    conv_job(F.in(1), MIN_TOT, DM, MIN_N, (bf16*)(ws + WS_WMIN), nmp, 512, scr, gw, NGW, F.lane);
    conv_job(F.in(4), DM, DM, DM, (bf16*)(ws + WS_WMOUT), nullptr, 0, scr, gw, NGW, F.lane);
    conv_job(F.in(5), AIN_N, DM, AIN_N, (bf16*)(ws + WS_WAIN), nmp + DM, 0, scr, gw, NGW, F.lane);
    conv_job(F.in(8), DM, DM, DM, (bf16*)(ws + WS_WAOUT), nullptr, 0, scr, gw, NGW, F.lane);
    conv_job(F.in(14), UP_N, DM, UP_N, (bf16*)(ws + WS_WUP0), nfp, 0, scr, gw, NGW, F.lane);
    conv_job(F.in(14) + (size_t)DM * UP_N, UP_N, DM, UP_N, (bf16*)(ws + WS_WUP1), nfp + DM, 0, scr, gw, NGW, F.lane);
    conv_job(F.in(17), DM, DFF, DM, (bf16*)(ws + WS_WDN0), nullptr, 0, scr, gw, NGW, F.lane);
    conv_job(F.in(17) + (size_t)DFF * DM, DM, DFF, DM, (bf16*)(ws + WS_WDN1), nullptr, 0, scr, gw, NGW, F.lane);
    const float* x = F.in(0); bf16* XN = (bf16*)(ws + WS_XN);
    const float* win = F.in(1); const float* gb = F.in(2);
    float* IG = (float*)(ws + WS_IG); float* LF = (float*)(ws + WS_LF);
    for (int m = gw; m < M; m += NGW) {
        const f32x4* xr = (const f32x4*)(x + (size_t)m * DM) + F.lane;
        f32x4 v[4]; float ss = 0.f;
#pragma unroll
        for (int j = 0; j < 4; ++j) { v[j] = xr[64 * j]; ss += (v[j].x * v[j].x + v[j].y * v[j].y) + (v[j].z * v[j].z + v[j].w * v[j].w); }
        const float rstd = 1.0f / sqrtf(wave_sum(ss) * (1.0f / DM) + EPS);
        unsigned long long* o8 = (unsigned long long*)(XN + (size_t)m * DM) + F.lane;
#pragma unroll
        for (int j = 0; j < 4; ++j) o8[64 * j] = (unsigned long long)pk2(v[j].x * rstd, v[j].y * rstd) | ((unsigned long long)pk2(v[j].z * rstd, v[j].w * rstd) << 32);
        float ga[16];
#pragma unroll
        for (int i = 0; i < 16; ++i) ga[i] = 0.f;
#pragma unroll
        for (int j = 0; j < 4; ++j)
#pragma unroll
            for (int e = 0; e < 4; ++e) { const int k = 4 * F.lane + 256 * j + e; const float xg = v[j][e] * nmp[k];
                const f32x4* wg = (const f32x4*)(win + (size_t)k * MIN_TOT + MIN_N);
#pragma unroll
                for (int q = 0; q < 4; ++q) { const f32x4 w = wg[q]; ga[4 * q] += xg * w.x; ga[4 * q + 1] += xg * w.y; ga[4 * q + 2] += xg * w.z; ga[4 * q + 3] += xg * w.w; } }
#pragma unroll
        for (int i = 0; i < 16; ++i) ga[i] = wave_sum(ga[i]) * rstd;
        if (F.lane == 0) { const int b = m >> 13, t = m & (SEQ - 1);
#pragma unroll
            for (int h = 0; h < 8; ++h) {
                IG[(size_t)(b * 8 + h) * SEQ + t] = softcap(ga[h] + gb[h]);
                LF[(size_t)(b * 8 + h) * SEQ + t] = logsig(softcap(ga[8 + h] + gb[8 + h])); } }
    }
}

__device__ __forceinline__ void mlstm_p2_simple(Frame& F) {
    LAS float* Ks = (LAS float*)F.lds;
    LAS float* Vs = Ks + 64 * 65;
    LAS float* gl = Vs + 64 * 129; LAS float* gi = gl + 64; LAS float* aa = gi + 64; LAS float* wsv = aa + 64; LAS float* sc = wsv + 64;
    const bf16* QKVO = (const bf16*)(F.ws + WS_QKVO); bf16* DC = (bf16*)(F.ws + WS_DC);
    const float* IG = (const float*)(F.ws + WS_IG); const float* LF = (const float*)(F.ws + WS_LF);
    float* DN = (float*)(F.ws + WS_DN); float* BL = (float*)(F.ws + WS_BL); float* AMX = (float*)(F.ws + WS_AMX);
    const int tid = F.tid;
    for (int u = blockIdx.x; u < NUNIT; u += gridDim.x) {
        const int bh = u >> 7, c = u & 127, b = bh >> 3, h = bh & 7; const size_t row0 = (size_t)b * SEQ + c * 64;
        if (tid < 64) { gl[tid] = LF[(size_t)bh * SEQ + c * 64 + tid]; gi[tid] = IG[(size_t)bh * SEQ + c * 64 + tid]; }
        __syncthreads();
        if (tid == 0) { float s = 0.f, amax = -INFINITY; for (int t = 0; t < 64; ++t) { s += gl[t]; const float a = gi[t] - s; aa[t] = a; amax = fmaxf(amax, a); } sc[0] = amax; sc[1] = s; }
        __syncthreads();
        if (tid < 64) wsv[tid] = expf(aa[tid] - sc[0]);
        __syncthreads();
#pragma unroll 1
        for (int i = tid; i < 64 * 64; i += 512) { const int s = i >> 6, d = i & 63; Ks[s * 65 + d] = wsv[s] * bf2f(QKVO[(row0 + s) * MIN_N + KOFF + h * 64 + d]); }
#pragma unroll 1
        for (int i = tid; i < 64 * 128; i += 512) { const int s = i >> 7, d = i & 127; Vs[s * 129 + d] = bf2f(QKVO[(row0 + s) * MIN_N + VOFF + h * 128 + d]); }
        __syncthreads();
#pragma unroll 1
        for (int j = 0; j < 16; ++j) { const int e = tid + j * 512, dv = e >> 6, dk = e & 63; float a = 0.f;
            for (int s = 0; s < 64; ++s) a += Ks[s * 65 + dk] * Vs[s * 129 + dv];
            DC[(size_t)u * 8192 + e] = f2bf(a); }
        if (tid < 64) { float a = 0.f; for (int s = 0; s < 64; ++s) a += Ks[s * 65 + tid]; DN[(size_t)u * 64 + tid] = a; }
        if (tid == 0) { BL[u] = sc[1]; AMX[u] = sc[0]; }
        __syncthreads();
    }
}
__device__ __forceinline__ void mlstm_p3_scan(Frame& F) {
    const bf16* DC = (const bf16*)(F.ws + WS_DC); bf16* CS = (bf16*)(F.ws + WS_CS);
    const float* DN = (const float*)(F.ws + WS_DN); float* NS = (float*)(F.ws + WS_NS);
    const float* BL = (const float*)(F.ws + WS_BL); const float* AMX = (const float*)(F.ws + WS_AMX); float* MS = (float*)(F.ws + WS_MS);
    for (int w = blockIdx.x; w < 256; w += gridDim.x) {
        const int bh = w >> 4, sl = w & 15, e = sl * 512 + F.tid; const bool nth = (sl == 0 && F.tid < 64);
        float C = 0.f, n = 0.f, m = 0.f;
#pragma unroll 8
        for (int c = 0; c < 128; ++c) { const int u = bh * 128 + c;
            const float bl = BL[u], am = AMX[u];
            CS[(size_t)u * 8192 + e] = f2bf(C);
            if (nth) NS[(size_t)u * 64 + F.tid] = n;
            if (sl == 0 && F.tid == 0) MS[u] = m;
            const float mt = bl + am, mn = fmaxf(bl + m, mt), dec = expf(bl + m - mn), scl = expf(mt - mn);
            C = dec * C + scl * bf2f(DC[(size_t)u * 8192 + e]);
            if (nth) n = dec * n + scl * DN[(size_t)u * 64 + F.tid];
            m = mn; }
    }
}
__device__ __forceinline__ void mlstm_p4_simple(Frame& F) {
    LAS float* Qs = (LAS float*)F.lds;
    LAS float* Ks = Qs + 64 * 65;
    LAS float* Vs = Ks + 64 * 65;
    LAS float* Cs = Vs + 64 * 129;
    LAS float* Ws = Cs + 128 * 65;
    LAS float* Hs = Ws + 64 * 65;
    LAS float* gl = Hs + 64 * 129; LAS float* gi = gl + 64; LAS float* aa = gi + 64; LAS float* bb = aa + 64; LAS float* Mt = bb + 64;
    LAS float* sint = Mt + 64; LAS float* eneg = sint + 64; LAS float* dinv = eneg + 64; LAS float* rs = dinv + 64; LAS float* nv = rs + 64;
    const bf16* QKVO = (const bf16*)(F.ws + WS_QKVO); const bf16* CS = (const bf16*)(F.ws + WS_CS); bf16* G = (bf16*)(F.ws + WS_G);
    const float* IG = (const float*)(F.ws + WS_IG); const float* LF = (const float*)(F.ws + WS_LF);
    const float* NS = (const float*)(F.ws + WS_NS); const float* MS = (const float*)(F.ws + WS_MS);
    const float* hnorm = F.in(3);
    const int tid = F.tid;
    for (int u = blockIdx.x; u < NUNIT; u += gridDim.x) {
        const int bh = u >> 7, c = u & 127, b = bh >> 3, h = bh & 7; const size_t row0 = (size_t)b * SEQ + c * 64;
        const float mc = MS[u];
        if (tid < 64) { gl[tid] = LF[(size_t)bh * SEQ + c * 64 + tid]; gi[tid] = IG[(size_t)bh * SEQ + c * 64 + tid]; nv[tid] = NS[(size_t)u * 64 + tid]; }
        __syncthreads();
        if (tid == 0) { float s = 0.f, cm = mc; for (int t = 0; t < 64; ++t) { s += gl[t]; bb[t] = s; const float a = gi[t] - s; aa[t] = a; cm = fmaxf(cm, a); Mt[t] = cm; } }
        __syncthreads();
        if (tid < 64) { sint[tid] = expf(mc - Mt[tid]); eneg[tid] = expf(-bb[tid] - Mt[tid]); }
#pragma unroll 1
        for (int i = tid; i < 64 * 64; i += 512) { const int s = i >> 6, d = i & 63;
            Qs[s * 65 + d] = bf2f(QKVO[(row0 + s) * MIN_N + QOFF + h * 64 + d]); Ks[s * 65 + d] = bf2f(QKVO[(row0 + s) * MIN_N + KOFF + h * 64 + d]); }
#pragma unroll 1
        for (int i = tid; i < 64 * 128; i += 512) { const int s = i >> 7, d = i & 127; Vs[s * 129 + d] = bf2f(QKVO[(row0 + s) * MIN_N + VOFF + h * 128 + d]); }
#pragma unroll 1
        for (int i = tid; i < 128 * 64; i += 512) { const int dv = i >> 6, dk = i & 63; Cs[dv * 65 + dk] = bf2f(CS[(size_t)u * 8192 + i]); }
        __syncthreads();
#pragma unroll 1
        for (int j = 0; j < 8; ++j) { const int i = tid + j * 512, t = i >> 6, s = i & 63; float w = 0.f;
            if (s <= t) { float d = 0.f; for (int k = 0; k < 64; ++k) d += Qs[t * 65 + k] * Ks[s * 65 + k]; w = d * expf(aa[s] - Mt[t]); }
            Ws[t * 65 + s] = w; }
        __syncthreads();
        if (tid < 64) { const int t = tid; float den = 0.f, qn = 0.f; for (int s = 0; s < 64; ++s) den += Ws[t * 65 + s];
            for (int k = 0; k < 64; ++k) qn += Qs[t * 65 + k] * nv[k];
            den += sint[t] * qn; dinv[t] = 1.0f / fmaxf(fabsf(den), eneg[t]); }
        __syncthreads();
#pragma unroll 1
        for (int j = 0; j < 16; ++j) { const int i = tid + j * 512, t = i >> 7, dv = i & 127; float a = 0.f, ci = 0.f;
            for (int s = 0; s < 64; ++s) a += Ws[t * 65 + s] * Vs[s * 129 + dv];
            for (int k = 0; k < 64; ++k) ci += Qs[t * 65 + k] * Cs[dv * 65 + k];
            Hs[t * 129 + dv] = (a + sint[t] * ci) * dinv[t]; }
        __syncthreads();
        if (tid < 64) { float ss = 0.f; for (int d = 0; d < 128; ++d) { const float v = Hs[tid * 129 + d]; ss += v * v; } rs[tid] = 1.0f / sqrtf(ss * (1.0f / 128.f) + EPS); }
        __syncthreads();
#pragma unroll 1
        for (int j = 0; j < 16; ++j) { const int i = tid + j * 512, t = i >> 7, dv = i & 127;
            const float o = bf2f(QKVO[(row0 + t) * MIN_N + OOFF + h * 128 + dv]);
            const float g = Hs[t * 129 + dv] * rs[t] * hnorm[h * 128 + dv] / (1.0f + expf(-o));
            G[(row0 + t) * DM + h * 128 + dv] = f2bf(g); }
        __syncthreads();
    }
}

__device__ __forceinline__ void attn_simple(Frame& F) {
    LAS float* Qs = (LAS float*)F.lds;
    LAS float* Ks = Qs + 32 * 65;
    LAS float* Vs = Ks + 160 * 65;
    LAS float* Ss = Vs + 160 * 65;
    LAS float* pinv = Ss + 32 * 161;
    const bf16* QKV = (const bf16*)(F.ws + WS_AQKV); bf16* AO = (bf16*)(F.ws + WS_AO);
    const float* sinks = F.in(7);
    const int tid = F.tid;
    for (int u = blockIdx.x; u < 2 * 16 * 256; u += gridDim.x) {
        const int b = u >> 12, hq = (u >> 8) & 15, qb = u & 255, kvh = hq >> 3; const int q0 = qb * 32, ks0 = q0 - 128;
        const size_t rb = (size_t)b * SEQ; const float sink = sinks[hq];
#pragma unroll 1
        for (int i = tid; i < 32 * 64; i += 512) { const int t = i >> 6, d = i & 63; Qs[t * 65 + d] = bf2f(QKV[(rb + q0 + t) * AIN_N + hq * 64 + d]); }
#pragma unroll 1
        for (int i = tid; i < 160 * 64; i += 512) { const int j = i >> 6, d = i & 63, kp = ks0 + j; float kv = 0.f, vv = 0.f;
            if (kp >= 0) { kv = bf2f(QKV[(rb + kp) * AIN_N + 1024 + kvh * 64 + d]); vv = bf2f(QKV[(rb + kp) * AIN_N + 1152 + kvh * 64 + d]); }
            Ks[j * 65 + d] = kv; Vs[j * 65 + d] = vv; }
        __syncthreads();
#pragma unroll 1
        for (int jj = 0; jj < 10; ++jj) { const int i = tid + jj * 512, t = i / 160, j = i % 160; const int qp = q0 + t, kp = ks0 + j, diff = qp - kp;
            float s = -INFINITY;
            if (kp >= 0 && diff >= 0 && diff < 128) { float d = 0.f; for (int k = 0; k < 64; ++k) d += Qs[t * 65 + k] * Ks[j * 65 + k]; s = d; }
            Ss[t * 161 + j] = s; }
        __syncthreads();
        if (tid < 32) { const int t = tid; float mx = sink; for (int j = 0; j < 160; ++j) mx = fmaxf(mx, Ss[t * 161 + j]);
            float sum = expf(sink - mx); for (int j = 0; j < 160; ++j) { const float s = Ss[t * 161 + j]; const float p = (s == -INFINITY) ? 0.f : expf(s - mx); Ss[t * 161 + j] = p; sum += p; }
            pinv[t] = 1.0f / sum; }
        __syncthreads();
#pragma unroll 1
        for (int jj = 0; jj < 4; ++jj) { const int i = tid + jj * 512, t = i >> 6, d = i & 63; float a = 0.f;
            for (int j = 0; j < 160; ++j) a += Ss[t * 161 + j] * Vs[j * 65 + d];
            AO[(rb + q0 + t) * DM + hq * 64 + d] = f2bf(a * pinv[t]); }
        __syncthreads();
    }
}

__device__ __forceinline__ void norm_res_rows(Frame& F, const float* Z, const float* bias, const float* base, const float* gpost, float* out, bf16* XN) {
    const int gw = blockIdx.x * 8 + F.wave, NGW = gridDim.x * 8;
    for (int m = gw; m < M; m += NGW) {
        const f32x4* zr = (const f32x4*)(Z + (size_t)m * DM) + F.lane; const f32x4* br = (const f32x4*)(base + (size_t)m * DM) + F.lane;
        f32x4 z[4], x1[4]; float ss = 0.f;
#pragma unroll
        for (int j = 0; j < 4; ++j) { z[j] = zr[64 * j]; if (bias) z[j] = z[j] + ((const f32x4*)bias)[F.lane + 64 * j];
            ss += (z[j].x * z[j].x + z[j].y * z[j].y) + (z[j].z * z[j].z + z[j].w * z[j].w); }
        const float r1 = 1.0f / sqrtf(wave_sum(ss) * (1.0f / DM) + EPS); float s2 = 0.f;
#pragma unroll
        for (int j = 0; j < 4; ++j) { const f32x4 g = ((const f32x4*)gpost)[F.lane + 64 * j]; x1[j] = br[64 * j] + z[j] * r1 * g;
            s2 += (x1[j].x * x1[j].x + x1[j].y * x1[j].y) + (x1[j].z * x1[j].z + x1[j].w * x1[j].w); }
        f32x4* orow = (f32x4*)(out + (size_t)m * DM) + F.lane;
#pragma unroll
        for (int j = 0; j < 4; ++j) orow[64 * j] = x1[j];
        if (XN) { const float r2 = 1.0f / sqrtf(wave_sum(s2) * (1.0f / DM) + EPS);
            unsigned long long* o8 = (unsigned long long*)(XN + (size_t)m * DM) + F.lane;
#pragma unroll
            for (int j = 0; j < 4; ++j) o8[64 * j] = (unsigned long long)pk2(x1[j].x * r2, x1[j].y * r2) | ((unsigned long long)pk2(x1[j].z * r2, x1[j].w * r2) << 32); }
    }
}

#define XB_TMO      128
#define XB_XCNT(j)  (256  + 64 * (j))
#define XB_XSUB(j)  (1280 + 64 * (j))
#define XB_XGEN(j)  (2304 + 64 * (j))
#define XB_TOP      3328
#define XB_TOPGEN   3392
#define XCD_BAR_WORDS 3456
#define XB_SPIN_CAP (1u << 20)
__device__ __forceinline__ unsigned xb_ld(unsigned* p)              { return __hip_atomic_load(p, __ATOMIC_RELAXED, __HIP_MEMORY_SCOPE_AGENT); }
__device__ __forceinline__ unsigned xb_add(unsigned* p, unsigned v) { return __hip_atomic_fetch_add(p, v, __ATOMIC_RELAXED, __HIP_MEMORY_SCOPE_AGENT); }
__device__ __forceinline__ unsigned xb_xcc_id() { return (unsigned)__builtin_amdgcn_s_getreg((3 << 11) | 20) & 0xFu; }
#define XB_SPIN(cond, bar) do { unsigned _sp = 0; while (cond) { __builtin_amdgcn_s_sleep(1); \
    if ((++_sp & 255u) == 0u) { if (xb_ld(&(bar)[XB_TMO])) break; if (_sp > XB_SPIN_CAP) { atomicAdd(&(bar)[XB_TMO], 1u); break; } } } } while (0)
struct XcdBarrier { unsigned* bar; unsigned x; volatile LAS unsigned* st; };
__device__ __forceinline__ XcdBarrier xcd_barrier_post(unsigned* bar, volatile LAS unsigned* st) {
    XcdBarrier b; b.bar = bar; b.x = xb_xcc_id(); b.st = st;
    if (threadIdx.x == 0) (void)xb_add(&bar[XB_XCNT(b.x)], 1u);
    return b;
}
__device__ __forceinline__ void xcd_barrier_complete(unsigned* bar, unsigned x, unsigned& nloc, unsigned& nx) {
    const unsigned G = gridDim.x * gridDim.y * gridDim.z;
    unsigned sum, cnt, mine, sp = 0u;
    for (;;) {
        sum = 0u; cnt = 0u; mine = 0u;
#pragma unroll
        for (unsigned j = 0; j < 16; ++j) { const unsigned c = xb_ld(&bar[XB_XCNT(j)]); sum += c; cnt += (c > 0u) ? 1u : 0u; mine = (j == x) ? c : mine; }
        if (sum == G) break;
        __builtin_amdgcn_s_sleep(1);
        if ((++sp & 255u) == 0u) { if (xb_ld(&bar[XB_TMO])) break; if (sp > XB_SPIN_CAP) { atomicAdd(&bar[XB_TMO], 1u); break; } }
    }
    nloc = mine > 0u ? mine : 1u; nx = cnt > 0u ? cnt : 1u;
}
__device__ __forceinline__ void xcd_barrier(const XcdBarrier& b) {
    asm volatile("s_waitcnt vmcnt(0)" ::: "memory");
    __syncthreads();
    if (threadIdx.x == 0) {
        unsigned* bar = b.bar;
        __builtin_amdgcn_s_waitcnt(0);
        unsigned nloc = b.st[0], nx = b.st[1];
        if (nloc == 0u) { xcd_barrier_complete(bar, b.x, nloc, nx); b.st[0] = nloc; b.st[1] = nx; }
        const unsigned old = xb_add(&bar[XB_XSUB(b.x)], 1u);
        const unsigned gen = old / nloc;
        if (old + 1u == (gen + 1u) * nloc) {
            __builtin_amdgcn_fence(__ATOMIC_RELEASE, "agent");
            asm volatile("s_waitcnt vmcnt(0)" ::: "memory");
            const unsigned og = xb_add(&bar[XB_TOP], 1u);
            const unsigned tg = og / nx;
            if (og + 1u == (tg + 1u) * nx) xb_add(&bar[XB_TOPGEN], 1u);
            else XB_SPIN(xb_ld(&bar[XB_TOPGEN]) == tg, bar);
            __builtin_amdgcn_fence(__ATOMIC_ACQUIRE, "agent");
            xb_add(&bar[XB_XGEN(b.x)], 1u);
            asm volatile("s_waitcnt vmcnt(0)" ::: "memory");
        } else {
            XB_SPIN(xb_ld(&bar[XB_XGEN(b.x)]) == gen, bar);
            __builtin_amdgcn_fence(__ATOMIC_ACQUIRE, "agent");
            asm volatile("s_waitcnt vmcnt(0)" ::: "memory");
        }
    }
    __syncthreads();
}

constexpr int MISC_OFF = LDS_BYTES - 256;
constexpr int PTAB_OFF = LDS_BYTES - 512;
constexpr int CW_BAR = 4096;
constexpr size_t CTL_ZERO_BYTES = 256 * 1024;

enum Kind { K_PRO = 0, K_GEMM_BF16, K_GEMM_F32, K_GEMM_CONV, K_M2, K_M3, K_M4, K_ATT, K_NR };
struct Step { int kind, bar; unsigned a, b, c, d; int nM, nN, K, i0, e0, i1, e1, x; };
#define U(x) ((unsigned)(x))
#define FFN_STEPS(L, WUP, WDN) \
    {K_GEMM_BF16, 1, U(WS_XN), U(WUP), U(WS_GT), U(DFF), 32, 11, DM, -1, 0, 0, 0, 0}, \
    {K_GEMM_CONV, 1, U(WS_XN), U(WUP + (size_t)DFF * DM * 2), U(WS_GT), U(WS_ACT), 32, 11, DM, 15, (L) * 3 * DFF, 16, (L) * DFF, 0}, \
    {K_GEMM_F32, 1, U(WS_ACT), U(WDN), U(WS_Z), 0, 32, 4, DFF, 0, 0, 0, 0, 0}, \
    {K_GEMM_BF16, 1, U(WS_XN + (size_t)SEQ * DM * 2), U(WUP), U(WS_GT), U(DFF), 32, 11, DM, -1, 0, 0, 0, 0}, \
    {K_GEMM_CONV, 1, U(WS_XN + (size_t)SEQ * DM * 2), U(WUP + (size_t)DFF * DM * 2), U(WS_GT), U(WS_ACT), 32, 11, DM, 15, (L) * 3 * DFF, 16, (L) * DFF, 0}, \
    {K_GEMM_F32, 1, U(WS_ACT), U(WDN), U(WS_Z + (size_t)SEQ * DM * 4), 0, 32, 4, DFF, 0, 0, 0, 0, 0}
__constant__ Step g_prog[] = {
    {K_PRO, 1, 0, 0, 0, 0, 0, 0, 0, 0, 0, 0, 0, 0},
    {K_GEMM_BF16, 1, U(WS_XN), U(WS_WMIN), U(WS_QKVO), U(MIN_N), 64, 12, DM, -1, 0, 0, 0, 0},
    {K_M2, 1, 0, 0, 0, 0, 0, 0, 0, 0, 0, 0, 0, 0},
    {K_M3, 1, 0, 0, 0, 0, 0, 0, 0, 0, 0, 0, 0, 0},
    {K_M4, 1, 0, 0, 0, 0, 0, 0, 0, 0, 0, 0, 0, 0},
    {K_GEMM_F32, 1, U(WS_G), U(WS_WMOUT), U(WS_Z), 0, 64, 4, DM, 0, 0, 0, 0, 0},
    {K_NR, 1, 0, 0, U(WS_Z), 0, 0, 0, 0, -1, 0, 11, 0, 2},
    FFN_STEPS(0, WS_WUP0, WS_WDN0),
    {K_NR, 1, 0, 0, U(WS_Z), 0, 0, 0, 0, -1, 0, 13, 0, 3},
    {K_GEMM_BF16, 1, U(WS_XN), U(WS_WAIN), U(WS_AQKV), U(AIN_N), 64, 5, DM, 6, 0, 0, 0, 1024},
    {K_ATT, 1, 0, 0, 0, 0, 0, 0, 0, 0, 0, 0, 0, 0},
    {K_GEMM_F32, 1, U(WS_AO), U(WS_WAOUT), U(WS_Z), 0, 64, 4, DM, 0, 0, 0, 0, 0},
    {K_NR, 1, 0, 0, U(WS_Z), 0, 0, 0, 0, 9, 0, 11, DM, 3},
    FFN_STEPS(1, WS_WUP1, WS_WDN1),
    {K_NR, 0, 0, 0, U(WS_Z), 0, 0, 0, 0, -1, 0, 13, DM, 1},
};
constexpr int NSTEPS = 1 + 6 + 6 + 1 + 4 + 6 + 1;

__global__ void __launch_bounds__(512, 2) skel_fwd(Args args) {
    extern __shared__ __attribute__((aligned(16))) unsigned char lds[];
    Frame F;
    F.lds = (LAS unsigned char*)lds; F.tid = threadIdx.x; F.lane = F.tid & 63; F.wave = __builtin_amdgcn_readfirstlane(F.tid >> 6); F.G = gridDim.x;
    F.ws = args.ws;
    unsigned char* ws = args.ws;
    volatile LAS unsigned* MISC = (volatile LAS unsigned*)(F.lds + MISC_OFF);
    if (F.tid < 64) MISC[F.tid] = 0u;
    if (F.tid < 19) ((LAS unsigned long long*)(F.lds + PTAB_OFF))[F.tid] = (F.tid < 18) ? (unsigned long long)args.in[F.tid] : (unsigned long long)args.out;
    __syncthreads();
    XcdBarrier bar = xcd_barrier_post((unsigned*)(ws + WS_CTL) + CW_BAR, MISC + 8);
#pragma unroll 1
    for (int si = 0; si < NSTEPS; ++si) {
        const Step st = g_prog[si];
        { int t_ = threadIdx.x; asm volatile("" : "+v"(t_)); F.tid = t_; F.lane = t_ & 63; F.wave = __builtin_amdgcn_readfirstlane(t_ >> 6);
          unsigned char* w_ = args.ws; asm volatile("" : "+s"(w_)); F.ws = w_; ws = w_; }
        switch (st.kind) {
        case K_PRO: p0_prologue(F); break;
        case K_GEMM_BF16: { EpiBf16 E{(bf16*)(ws + st.c), (int)st.d, st.i0 >= 0 ? F.in(st.i0) + st.e0 : nullptr, st.x, 0.125f};
            gemm_simple(F, (const bf16*)(ws + st.a), (const bf16*)(ws + st.b), st.nM, st.nN, st.K, E); } break;
        case K_GEMM_F32: { EpiF32 E{(float*)(ws + st.c), DM}; gemm_simple(F, (const bf16*)(ws + st.a), (const bf16*)(ws + st.b), st.nM, st.nN, st.K, E); } break;
        case K_GEMM_CONV: { EpiConv E{(const bf16*)(ws + st.c), (bf16*)(ws + st.d), F.in(st.i0) + st.e0, F.in(st.i1) + st.e1};
            gemm_simple(F, (const bf16*)(ws + st.a), (const bf16*)(ws + st.b), st.nM, st.nN, st.K, E); } break;
        case K_M2: mlstm_p2_simple(F); break;
        case K_M3: mlstm_p3_scan(F); break;
        case K_M4: mlstm_p4_simple(F); break;
        case K_ATT: attn_simple(F); break;
        case K_NR: norm_res_rows(F, (const float*)(ws + st.c), st.i0 >= 0 ? F.in(st.i0) + st.e0 : nullptr, (st.x & 1) ? (const float*)F.out() : F.in(0), F.in(st.i1) + st.e1, F.out(), (st.x & 2) ? (bf16*)(ws + WS_XN) : nullptr); break;
        default: break;
        }
        if (st.bar) xcd_barrier(bar);
    }
}

extern "C" void kernel_launch(void* const* d_in, const int* in_sizes, int n_in, void* d_out, int out_size, void* d_ws, size_t ws_size, hipStream_t stream) {
    static int grid = 0;
    if (grid == 0) {
        if (n_in != 18 || in_sizes[0] != M * DM || out_size != M * DM || ws_size < WS_END) { fprintf(stderr, "kernel_launch: unexpected shapes (n_in %d, in0 %d, out %d, ws %zu)\n", n_in, n_in > 0 ? in_sizes[0] : -1, out_size, ws_size); grid = -1; return; }
        int dev = 0, cus = 0, per_cu = 0;
        (void)hipGetDevice(&dev); (void)hipDeviceGetAttribute(&cus, hipDeviceAttributeMultiprocessorCount, dev);
        if (hipFuncSetAttribute((const void*)skel_fwd, hipFuncAttributeMaxDynamicSharedMemorySize, LDS_BYTES) != hipSuccess) { fprintf(stderr, "kernel_launch: hipFuncSetAttribute failed\n"); grid = -1; return; }
        if (hipOccupancyMaxActiveBlocksPerMultiprocessor(&per_cu, (const void*)skel_fwd, 512, LDS_BYTES) != hipSuccess || per_cu < 1) { fprintf(stderr, "kernel_launch: occupancy query says %d blocks per CU\n", per_cu); per_cu = 1; }
        (void)hipGetLastError();
        grid = cus > 0 ? cus : 256;
    }
    if (grid < 0) return;
    (void)hipMemsetAsync((char*)d_ws + WS_CTL, 0, CTL_ZERO_BYTES, stream);
    Args a{};
    for (int i = 0; i < 18; ++i) a.in[i] = (const float*)d_in[i];
    a.out = (float*)d_out; a.ws = (unsigned char*)d_ws;
    hipLaunchKernelGGL(skel_fwd, dim3(grid), dim3(512), LDS_BYTES, stream, a);
}
```

```cpp
#include <hip/hip_runtime.h>
#include <cstdio>
#include <cstdint>

#define LAS __attribute__((address_space(3)))
typedef unsigned short bf16;
typedef short bf16x8 __attribute__((ext_vector_type(8)));
typedef float f32x4 __attribute__((ext_vector_type(4)));
typedef float f32x2 __attribute__((ext_vector_type(2)));
typedef unsigned u32x4 __attribute__((ext_vector_type(4)));
typedef unsigned u32x2 __attribute__((ext_vector_type(2)));
typedef __bf16 bf16x2_t __attribute__((ext_vector_type(2)));

constexpr int SEQ = 8192, DM = 1024, M = 16384;
constexpr int MIN_N = 3072, MIN_TOT = 3088;
constexpr int QOFF = 0, KOFF = 512, VOFF = 1024, OOFF = 2048;
constexpr int AIN_N = 1280;
constexpr int DFF = 2816, UP_N = 5632;
constexpr float EPS = 1e-6f, GCAP = 15.0f;
constexpr int NUNIT = 2048;

constexpr size_t MiB = 1u << 20;
constexpr size_t WS_CTL = 0;
constexpr size_t WS_WMIN = 1 * MiB, WS_WMOUT = 7 * MiB, WS_WAIN = 9 * MiB, WS_WAOUT = 12 * MiB;
constexpr size_t WS_WUP0 = 14 * MiB, WS_WUP1 = 25 * MiB, WS_WDN0 = 36 * MiB, WS_WDN1 = 42 * MiB;
constexpr size_t WS_IG = 48 * MiB, WS_LF = WS_IG + 512 * 1024, WS_DN = 49 * MiB, WS_NS = WS_DN + 512 * 1024;
constexpr size_t WS_BL = 50 * MiB, WS_AMX = WS_BL + 8192, WS_MS = WS_AMX + 8192;
constexpr size_t WS_XN = 52 * MiB;
constexpr size_t WS_R = 84 * MiB;
constexpr size_t WS_QKVO = WS_R, WS_DC = 180 * MiB, WS_G = 180 * MiB, WS_CS = 212 * MiB;
constexpr size_t WS_GT = WS_R, WS_ACT = 128 * MiB, WS_Z = 172 * MiB;
constexpr size_t WS_AQKV = WS_R, WS_AO = 124 * MiB;
constexpr size_t WS_END = 256 * MiB;

constexpr int LDS_BYTES = 163840;

__device__ __forceinline__ unsigned pk2(float lo, float hi) { f32x2 v = {lo, hi}; bf16x2_t b = __builtin_convertvector(v, bf16x2_t); return __builtin_bit_cast(unsigned, b); }
__device__ __forceinline__ bf16 f2bf(float f) { return (bf16)(pk2(f, 0.f) & 0xffffu); }
__device__ __forceinline__ float bf2f(bf16 h) { return __uint_as_float(((unsigned)h) << 16); }
__device__ __forceinline__ float shi(float v, int src) { return __int_as_float(__builtin_amdgcn_ds_bpermute(src << 2, __float_as_int(v))); }
__device__ __forceinline__ float shx(float v, int mask, int lane) { return shi(v, lane ^ mask); }
__device__ __forceinline__ float wave_sum(float v, int lane) {
#pragma unroll
    for (int o = 1; o < 64; o <<= 1) v += shx(v, o, lane);
    return v;
}
__device__ __forceinline__ float softcap(float z) { return GCAP * tanhf(z * (1.0f / GCAP)); }
__device__ __forceinline__ float logsig(float x) { return fminf(x, 0.f) - log1pf(expf(-fabsf(x))); }

struct Args {
    const float* in[18]; float* out; unsigned char* ws;
    int phase, layer, half, pad;
};

struct Frame {
    LAS unsigned char* lds;
    int tid, lane, wave, G;
    unsigned char* ws;
    __device__ __forceinline__ const float* in(int i) const {
        const unsigned long long v = ((const LAS unsigned long long*)(lds + (LDS_BYTES - 512)))[i];
        const unsigned lo = __builtin_amdgcn_readfirstlane((unsigned)v), hi = __builtin_amdgcn_readfirstlane((unsigned)(v >> 32));
        return (const float*)(((unsigned long long)hi << 32) | lo); }
    __device__ __forceinline__ float* out() const { return (float*)in(18); }
};

namespace pg8 {
#define PG8_LAS __attribute__((address_space(3)))
typedef unsigned short bf16_t;
typedef short bf16x8 __attribute__((ext_vector_type(8)));
typedef float f32x4 __attribute__((ext_vector_type(4)));
typedef unsigned u32x4 __attribute__((ext_vector_type(4)));
constexpr int BM = 256, BK = 64, HALF = 128, HTB = HALF * BK * 2  , STAGE_BYTES = 8 * HTB, NXCD = 8, WGM = 8;

__host__ __device__ __forceinline__ int lds_byte(int r, int c) { const int st = (r >> 4) * 2 + (c >> 5), rr = r & 15, cc = c & 31, ob = rr * 64 + cc * 2; return st * 1024 + (ob ^ (((ob >> 9) & 1) << 5)); }
__host__ __device__ __forceinline__ void stage_rc(int b, int& R, int& C) { const int st = b / 1024, sb = b % 1024, swz = sb ^ (((sb >> 9) & 1) << 5); R = (st >> 1) * 16 + swz / 64; C = (st & 1) * 32 + (swz % 64) / 2; }
__host__ __device__ __forceinline__ int perm32(int rho) { const int n = rho >> 4, i = rho & 15; return 8 * (i >> 2) + 4 * n + (i & 3); }

struct Unit { int pm, pn; };
struct Gemm { const bf16_t* A; const bf16_t* Bt; int M, N, K; };

struct StaticOrder {
    int nM, nN, nwg, G, c;
    __host__ __device__ void init(int M, int N, int G_, int c_) { nM = M / BM; nN = N / BM; nwg = nM * nN; G = G_; c = c_; }
    __host__ __device__ bool next(int i, Unit& u) const {
        const long L = (long)i * G + c; if (L >= nwg) return false;
        int wgid = (int)L; { const int q = nwg / NXCD, r = nwg % NXCD, xcd = wgid % NXCD, off = wgid / NXCD; wgid = (xcd < r ? xcd * (q + 1) : r * (q + 1) + (xcd - r) * q) + off; }
        const int nig = WGM * nN, gid = wgid / nig, fm = gid * WGM, gsz = (nM - fm) < WGM ? (nM - fm) : WGM;
        u.pm = fm + ((wgid % nig) % gsz); u.pn = (wgid % nig) / gsz; return true;
    }
    __device__ __forceinline__ void a_ready(const Unit&) const {}
    __device__ __forceinline__ void done(const Unit&) const {}
};

template <class Epi, class Sched, bool ALIGN_EPI = false, bool SP2 = false>
__device__ __forceinline__ void gemm_phase(PG8_LAS unsigned char* lds, const Gemm g, const Sched& S, const Epi& E) {
    int tid_ = threadIdx.x; asm volatile("" : "+v"(tid_));
    const int tid = tid_, wid = __builtin_amdgcn_readfirstlane(tid >> 6), lane = tid & 63, wr = wid >> 2, wc = wid & 3, fr = lane & 15, fq = lane >> 4;
    const int K = g.K, nt = K / BK;
    unsigned voffA[2], voffB[2];
#pragma unroll
    for (int i = 0; i < 2; ++i) { int R, C; stage_rc(tid * 16 + i * 8192, R, C); const int Rb = Epi::PERM ? ((R & ~31) + perm32(R & 31)) : R;
        voffA[i] = (unsigned)(R * K + C) * 2u; voffB[i] = (unsigned)(Rb * K + C) * 2u; }
    const size_t kstep = (size_t)(BK * 2);
    const size_t hstep = (size_t)HALF * K * 2;
    const size_t tstep = 2 * hstep;
    const unsigned ldsw = (unsigned)wid * 1024u;
    const int aoff = lds_byte(wr * 64 + fr, fq * 8), boff = lds_byte(wc * 32 + fr, fq * 8);
#define PG8_SA(b, h) (((b) * 2 + (h)) * HTB)
#define PG8_SB(b, h) ((4 + (b) * 2 + (h)) * HTB)
#define PG8_STAGE(bufoff, gbase, voff) do { _Pragma("unroll") for (int _i = 0; _i < 2; ++_i) \
        __builtin_amdgcn_global_load_lds((const unsigned*)((const char*)(gbase) + (voff)[_i]), (PG8_LAS unsigned*)(lds + (bufoff) + ldsw + _i * 8192), 16, 0, 0); } while (0)
#define PG8_LDA(dst, b, h) do { _Pragma("unroll") for (int m = 0; m < 4; ++m) _Pragma("unroll") for (int k = 0; k < 2; ++k) dst[m][k] = *(const PG8_LAS bf16x8*)(lds + PG8_SA(b, h) + aoff + m * 2048 + k * 1024); } while (0)
#define PG8_LDB(dst, b, h) do { _Pragma("unroll") for (int n = 0; n < 2; ++n) _Pragma("unroll") for (int k = 0; k < 2; ++k) dst[n][k] = *(const PG8_LAS bf16x8*)(lds + PG8_SB(b, h) + boff + n * 2048 + k * 1024); } while (0)
#define PG8_MMA(ai, bj, At, Bt) do { __builtin_amdgcn_s_setprio(1); _Pragma("unroll") for (int m = 0; m < 4; ++m) _Pragma("unroll") for (int n = 0; n < 2; ++n) _Pragma("unroll") for (int k = 0; k < 2; ++k) \
        acc[ai][bj][m][n] = __builtin_amdgcn_mfma_f32_16x16x32_bf16(Bt[n][k], At[m][k], acc[ai][bj][m][n], 0, 0, 0); __builtin_amdgcn_s_setprio(0); } while (0)
#define PG8_WAIT_V(n) asm volatile("s_waitcnt vmcnt(" #n ")" ::: "memory")
#define PG8_WAIT_L(n) asm volatile("s_waitcnt lgkmcnt(" #n ")" ::: "memory")
#define PG8_BAR __builtin_amdgcn_s_barrier()
#define PG8_SCHED __builtin_amdgcn_sched_barrier(0)
    Unit cur, nxt; int ui = 0;
    if (!S.next(0, cur)) return;
    f32x4 acc[2][2][4][2];
#pragma unroll
    for (int a = 0; a < 2; ++a)
#pragma unroll
        for (int b = 0; b < 2; ++b)
#pragma unroll
            for (int m = 0; m < 4; ++m)
#pragma unroll
                for (int n = 0; n < 2; ++n) acc[a][b][m][n] = (f32x4){0.f, 0.f, 0.f, 0.f};
    bf16x8 At[4][2], B0[2][2], B1[2][2];
    const char* cA = (const char*)g.A + (size_t)cur.pm * tstep; const char* cB = (const char*)g.Bt + (size_t)cur.pn * tstep;
    S.a_ready(cur);
    if constexpr (SP2) {
        PG8_STAGE(PG8_SB(0, 0), cB, voffB); PG8_STAGE(PG8_SB(0, 1), cB + hstep, voffB); PG8_STAGE(PG8_SA(0, 0), cA, voffA); PG8_STAGE(PG8_SA(0, 1), cA + hstep, voffA);
        if (wr == 1) PG8_BAR;
        PG8_WAIT_V(2); PG8_BAR;
        PG8_STAGE(PG8_SB(1, 0), cB + kstep, voffB); PG8_STAGE(PG8_SA(1, 0), cA + kstep, voffA); PG8_STAGE(PG8_SB(1, 1), cB + hstep + kstep, voffB);
        PG8_WAIT_V(6); PG8_BAR;
    } else {
        PG8_STAGE(PG8_SB(0, 0), cB, voffB); PG8_STAGE(PG8_SA(0, 0), cA, voffA); PG8_STAGE(PG8_SB(0, 1), cB + hstep, voffB); PG8_STAGE(PG8_SA(0, 1), cA + hstep, voffA);
        if (wr == 1) PG8_BAR;
        PG8_WAIT_V(4); PG8_BAR;
        PG8_STAGE(PG8_SB(1, 0), cB + kstep, voffB); PG8_STAGE(PG8_SA(1, 0), cA + kstep, voffA); PG8_STAGE(PG8_SB(1, 1), cB + hstep + kstep, voffB);
        PG8_WAIT_V(6); PG8_BAR;
    }
    for (;;) {
        const bool has_next = S.next(ui + 1, nxt);
        const char* nA = has_next ? (const char*)g.A + (size_t)nxt.pm * tstep : cA; const char* nB = has_next ? (const char*)g.Bt + (size_t)nxt.pn * tstep : cB;
        for (int t = 0; t < nt; t += 2) {
            const bool last = (t == nt - 2);
            const char* a1 = cA + (size_t)(t + 1) * kstep;
            const char* a2 = last ? nA : cA + (size_t)(t + 2) * kstep; const char* b2 = last ? nB : cB + (size_t)(t + 2) * kstep;
            const char* a3 = a2 + kstep; const char* b3 = b2 + kstep;
            if (last && has_next) S.a_ready(nxt);
            if constexpr (SP2) {
            PG8_LDB(B0, 0, 0); PG8_LDB(B1, 0, 1); PG8_SCHED; PG8_LDA(At, 0, 0); PG8_STAGE(PG8_SA(1, 1), a1 + hstep, voffA);
            PG8_WAIT_V(8); PG8_WAIT_L(0); PG8_BAR; PG8_MMA(0, 0, At, B0); PG8_MMA(0, 1, At, B1); PG8_BAR; PG8_SCHED;
            PG8_LDA(At, 0, 1); PG8_STAGE(PG8_SB(0, 0), b2, voffB); PG8_STAGE(PG8_SB(0, 1), b2 + hstep, voffB); PG8_STAGE(PG8_SA(0, 0), a2, voffA);
            PG8_WAIT_V(8); PG8_WAIT_L(0); PG8_BAR; PG8_MMA(1, 0, At, B0); PG8_MMA(1, 1, At, B1); PG8_BAR; PG8_SCHED;
            PG8_LDB(B0, 1, 0); PG8_LDB(B1, 1, 1); PG8_SCHED; PG8_LDA(At, 1, 0); PG8_STAGE(PG8_SA(0, 1), a2 + hstep, voffA);
            PG8_WAIT_V(8); PG8_WAIT_L(0); PG8_BAR; PG8_MMA(0, 0, At, B0); PG8_MMA(0, 1, At, B1); PG8_BAR; PG8_SCHED;
            PG8_LDA(At, 1, 1); PG8_STAGE(PG8_SB(1, 0), b3, voffB); PG8_STAGE(PG8_SB(1, 1), b3 + hstep, voffB); PG8_STAGE(PG8_SA(1, 0), a3, voffA);
            PG8_WAIT_V(8); PG8_WAIT_L(0); PG8_BAR; PG8_MMA(1, 0, At, B0); PG8_MMA(1, 1, At, B1); PG8_BAR; PG8_SCHED;
            } else {
            PG8_LDB(B0, 0, 0); PG8_SCHED; PG8_LDA(At, 0, 0); PG8_STAGE(PG8_SA(1, 1), a1 + hstep, voffA);
            PG8_WAIT_L(8); PG8_BAR; PG8_WAIT_L(0); PG8_MMA(0, 0, At, B0); PG8_BAR; PG8_SCHED;
            PG8_LDB(B1, 0, 1); PG8_STAGE(PG8_SB(0, 0), b2, voffB);
            PG8_BAR; PG8_WAIT_L(0); PG8_MMA(0, 1, At, B1); PG8_BAR;
            PG8_LDA(At, 0, 1); PG8_STAGE(PG8_SA(0, 0), a2, voffA);
            PG8_BAR; PG8_WAIT_L(0); PG8_MMA(1, 0, At, B0); PG8_BAR; PG8_SCHED;
            PG8_STAGE(PG8_SB(0, 1), b2 + hstep, voffB);
            PG8_WAIT_V(6); PG8_BAR; PG8_MMA(1, 1, At, B1); PG8_BAR;
            PG8_LDB(B0, 1, 0); PG8_SCHED; PG8_LDA(At, 1, 0); PG8_STAGE(PG8_SA(0, 1), a2 + hstep, voffA);
            PG8_WAIT_L(8); PG8_BAR; PG8_WAIT_L(0); PG8_MMA(0, 0, At, B0); PG8_BAR; PG8_SCHED;
            PG8_LDB(B1, 1, 1); PG8_STAGE(PG8_SB(1, 0), b3, voffB);
            PG8_BAR; PG8_WAIT_L(0); PG8_MMA(0, 1, At, B1); PG8_BAR;
            PG8_LDA(At, 1, 1); PG8_STAGE(PG8_SA(1, 0), a3, voffA);
            PG8_BAR; PG8_WAIT_L(0); PG8_MMA(1, 0, At, B0); PG8_BAR; PG8_SCHED;
            PG8_STAGE(PG8_SB(1, 1), b3 + hstep, voffB);
            PG8_WAIT_V(6); PG8_BAR; PG8_MMA(1, 1, At, B1); PG8_BAR;
            }
        }
        if constexpr (ALIGN_EPI) { if (wr == 0) PG8_BAR; }
        if constexpr (!Epi::AFTER_DRAIN) { E(acc, cur, wr, wc, fr, fq); S.done(cur); }
        if (!has_next) break;
#pragma unroll
        for (int a = 0; a < 2; ++a)
#pragma unroll
            for (int b = 0; b < 2; ++b)
#pragma unroll
                for (int m = 0; m < 4; ++m)
#pragma unroll
                    for (int n = 0; n < 2; ++n) acc[a][b][m][n] = (f32x4){0.f, 0.f, 0.f, 0.f};
        cur = nxt; cA = nA; cB = nB; ++ui;
        if constexpr (ALIGN_EPI) { if (wr == 1) PG8_BAR; }
    }
    PG8_WAIT_V(0);
    if constexpr (!ALIGN_EPI) { if (wr == 0) PG8_BAR; }
    PG8_BAR;
    if constexpr (Epi::AFTER_DRAIN) { E.fused(acc, cur, wr, wc, fr, fq, lds, wid, lane); S.done(cur); }
#undef PG8_SA
#undef PG8_SB
#undef PG8_STAGE
#undef PG8_LDA
#undef PG8_LDB
#undef PG8_MMA
#undef PG8_WAIT_V
#undef PG8_WAIT_L
#undef PG8_BAR
#undef PG8_SCHED
}
}
using pg8::Unit;

struct EpiBf16 {
    static constexpr bool PERM = true, AFTER_DRAIN = false;
    bf16* O; int ldc; const float* bias; int scale_cols; float scale;
    __device__ __forceinline__ void operator()(const f32x4 (&acc)[2][2][4][2], const Unit& u, int wr, int wc, int fr, int fq) const {
        const int row0 = u.pm * 256 + wr * 64 + fr, col0 = u.pn * 256 + wc * 32 + 8 * fq;
#pragma unroll
        for (int ai = 0; ai < 2; ++ai)
#pragma unroll
            for (int m = 0; m < 4; ++m) { bf16* rowp = O + (size_t)(row0 + ai * 128 + m * 16) * ldc + col0;
#pragma unroll
                for (int bj = 0; bj < 2; ++bj) {
                    f32x4 v0 = acc[ai][bj][m][0], v1 = acc[ai][bj][m][1];
                    const int c = col0 + bj * 128;
                    if (bias) { v0 = v0 + *(const f32x4*)(bias + c); v1 = v1 + *(const f32x4*)(bias + c + 4); }
                    const float sc = (c < scale_cols) ? scale : 1.f; v0 = v0 * sc; v1 = v1 * sc;
                    u32x4 w; w.x = pk2(v0[0], v0[1]); w.y = pk2(v0[2], v0[3]); w.z = pk2(v1[0], v1[1]); w.w = pk2(v1[2], v1[3]);
                    *(u32x4*)(rowp + bj * 128) = w; } }
    }
};
struct EpiF32 {
    static constexpr bool PERM = false, AFTER_DRAIN = false;
    float* Z; int ldc;
    __device__ __forceinline__ void operator()(const f32x4 (&acc)[2][2][4][2], const Unit& u, int wr, int wc, int fr, int fq) const {
        const int row0 = u.pm * 256 + wr * 64 + fr, col0 = u.pn * 256 + wc * 32 + 4 * fq;
#pragma unroll
        for (int ai = 0; ai < 2; ++ai)
#pragma unroll
            for (int m = 0; m < 4; ++m)
#pragma unroll
                for (int bj = 0; bj < 2; ++bj)
#pragma unroll
                    for (int n = 0; n < 2; ++n)
                        *(f32x4*)(Z + (size_t)(row0 + ai * 128 + m * 16) * ldc + col0 + bj * 128 + n * 16) = acc[ai][bj][m][n];
    }
};
struct EpiConv {
    static constexpr bool PERM = true, AFTER_DRAIN = false;
    const bf16* Gt; bf16* ACT; const float* cw; const float* cb;
    __device__ __forceinline__ void operator()(const f32x4 (&acc)[2][2][4][2], const Unit& u, int wr, int wc, int fr, int fq) const {
        const int row0 = u.pm * 256 + wr * 64 + fr, col0 = u.pn * 256 + wc * 32 + 8 * fq;
#pragma unroll
        for (int ai = 0; ai < 2; ++ai)
#pragma unroll
            for (int m = 0; m < 4; ++m) { const int t = row0 + ai * 128 + m * 16;
#pragma unroll
                for (int bj = 0; bj < 2; ++bj) { const int c = col0 + bj * 128;
                    const u32x4 z4 = {0u, 0u, 0u, 0u};
                    const u32x4 g0 = *(const u32x4*)(Gt + (size_t)t * DFF + c);
                    const u32x4 g1 = (t >= 1) ? *(const u32x4*)(Gt + (size_t)(t - 1) * DFF + c) : z4;
                    const u32x4 g2 = (t >= 2) ? *(const u32x4*)(Gt + (size_t)(t - 2) * DFF + c) : z4;
                    float o[8];
#pragma unroll
                    for (int e = 0; e < 8; ++e) {
                        const unsigned w0 = g0[e >> 1], w1 = g1[e >> 1], w2 = g2[e >> 1];
                        const float a0 = (e & 1) ? __uint_as_float(w0 & 0xffff0000u) : __uint_as_float(w0 << 16);
                        const float a1 = (e & 1) ? __uint_as_float(w1 & 0xffff0000u) : __uint_as_float(w1 << 16);
                        const float a2 = (e & 1) ? __uint_as_float(w2 & 0xffff0000u) : __uint_as_float(w2 << 16);
                        const float gc = cb[c + e] + cw[c + e] * a2 + cw[DFF + c + e] * a1 + cw[2 * DFF + c + e] * a0;
                        const float v = acc[ai][bj][m][e >> 2][e & 3];
                        o[e] = gc / (1.f + __expf(-gc)) * v;
                    }
                    u32x4 w; w.x = pk2(o[0], o[1]); w.y = pk2(o[2], o[3]); w.z = pk2(o[4], o[5]); w.w = pk2(o[6], o[7]);
                    *(u32x4*)(ACT + (size_t)t * DFF + c) = w; } }
    }
};

__device__ __forceinline__ void transpose_item(const float* W, int ldw, int srcc, int K, int kb, bf16* WT, int drow, const float* gain, float scale, LAS float* scr, int lane) {
    const int k0 = 64 * kb;
#pragma unroll 8
    for (int i = 0; i < 32; ++i) { const int kk = 2 * i + (lane >> 5); float v = W[(size_t)(k0 + kk) * ldw + srcc + (lane & 31)];
        if (gain) v *= gain[k0 + kk];
        scr[kk * 33 + (lane & 31)] = v * scale; }
    asm volatile("s_waitcnt lgkmcnt(0)" ::: "memory");
    const int c = lane & 7;
#pragma unroll
    for (int j = 0; j < 4; ++j) { const int n = (lane >> 3) + 8 * j; const LAS float* s = scr + (8 * c) * 33 + n;
        u32x4 o; o.x = pk2(s[0 * 33], s[1 * 33]); o.y = pk2(s[2 * 33], s[3 * 33]); o.z = pk2(s[4 * 33], s[5 * 33]); o.w = pk2(s[6 * 33], s[7 * 33]);
        *(u32x4*)(WT + (size_t)(drow + n) * K + k0 + 8 * c) = o; }
    asm volatile("s_waitcnt lgkmcnt(0)" ::: "memory");
}
__device__ __forceinline__ void conv_job(const float* W, int ldw, int K, int N, bf16* WT, const float* gain, int qcols, LAS float* scr, int gw, int NGW, int lane) {
    const int nblk = N / 32, nit = (K / 64) * nblk;
    for (int it = gw; it < nit; it += NGW) { const int kb = it / nblk, nb = it % nblk;
        transpose_item(W, ldw, nb * 32, K, kb, WT, nb * 32, gain, (nb * 32 < qcols) ? 0.125f : 1.0f, scr, lane); }
}
__device__ __forceinline__ void p0_prologue(Frame& F) {
    LAS float* scr = (LAS float*)(F.lds + F.wave * 16384);
    const int gw = blockIdx.x * 8 + F.wave, NGW = gridDim.x * 8;
    unsigned char* ws = F.ws;
    const float* nmp = F.in(10); const float* nfp = F.in(12);
    conv_job(F.in(1), MIN_TOT, DM, MIN_N, (bf16*)(ws + WS_WMIN), nmp, 512, scr, gw, NGW, F.lane);
    conv_job(F.in(4), DM, DM, DM, (bf16*)(ws + WS_WMOUT), nullptr, 0, scr, gw, NGW, F.lane);
    conv_job(F.in(5), AIN_N, DM, AIN_N, (bf16*)(ws + WS_WAIN), nmp + DM, 0, scr, gw, NGW, F.lane);
    conv_job(F.in(8), DM, DM, DM, (bf16*)(ws + WS_WAOUT), nullptr, 0, scr, gw, NGW, F.lane);
    conv_job(F.in(14), UP_N, DM, UP_N, (bf16*)(ws + WS_WUP0), nfp, 0, scr, gw, NGW, F.lane);
    conv_job(F.in(14) + (size_t)DM * UP_N, UP_N, DM, UP_N, (bf16*)(ws + WS_WUP1), nfp + DM, 0, scr, gw, NGW, F.lane);
    conv_job(F.in(17), DM, DFF, DM, (bf16*)(ws + WS_WDN0), nullptr, 0, scr, gw, NGW, F.lane);
    conv_job(F.in(17) + (size_t)DFF * DM, DM, DFF, DM, (bf16*)(ws + WS_WDN1), nullptr, 0, scr, gw, NGW, F.lane);
    const float* x = F.in(0); bf16* XN = (bf16*)(ws + WS_XN);
    const float* win = F.in(1); const float* gb = F.in(2);
    float* IG = (float*)(ws + WS_IG); float* LF = (float*)(ws + WS_LF);
    for (int m = gw; m < M; m += NGW) {
        const f32x4* xr = (const f32x4*)(x + (size_t)m * DM) + F.lane;
        f32x4 v[4]; float ss = 0.f;
#pragma unroll
        for (int j = 0; j < 4; ++j) { v[j] = xr[64 * j]; ss += (v[j].x * v[j].x + v[j].y * v[j].y) + (v[j].z * v[j].z + v[j].w * v[j].w); }
        const float rstd = 1.0f / sqrtf(wave_sum(ss, F.lane) * (1.0f / DM) + EPS);
        unsigned long long* o8 = (unsigned long long*)(XN + (size_t)m * DM) + F.lane;
#pragma unroll
        for (int j = 0; j < 4; ++j) o8[64 * j] = (unsigned long long)pk2(v[j].x * rstd, v[j].y * rstd) | ((unsigned long long)pk2(v[j].z * rstd, v[j].w * rstd) << 32);
        float ga[16];
#pragma unroll
        for (int i = 0; i < 16; ++i) ga[i] = 0.f;
#pragma unroll
        for (int j = 0; j < 4; ++j)
#pragma unroll
            for (int e = 0; e < 4; ++e) { const int k = 4 * F.lane + 256 * j + e; const float xg = v[j][e] * nmp[k];
                const f32x4* wg = (const f32x4*)(win + (size_t)k * MIN_TOT + MIN_N);
#pragma unroll
                for (int q = 0; q < 4; ++q) { const f32x4 w = wg[q]; ga[4 * q] += xg * w.x; ga[4 * q + 1] += xg * w.y; ga[4 * q + 2] += xg * w.z; ga[4 * q + 3] += xg * w.w; } }
#pragma unroll
        for (int i = 0; i < 16; ++i) ga[i] = wave_sum(ga[i], F.lane) * rstd;
        if (F.lane == 0) { const int b = m >> 13, t = m & (SEQ - 1);
#pragma unroll
            for (int h = 0; h < 8; ++h) {
                IG[(size_t)(b * 8 + h) * SEQ + t] = softcap(ga[h] + gb[h]);
                LF[(size_t)(b * 8 + h) * SEQ + t] = logsig(softcap(ga[8 + h] + gb[8 + h])); } }
    }
}

__device__ __forceinline__ void mlstm_p2_simple(Frame& F) {
    LAS float* Ks = (LAS float*)F.lds;
    LAS float* Vs = Ks + 64 * 65;
    LAS float* gl = Vs + 64 * 129; LAS float* gi = gl + 64; LAS float* aa = gi + 64; LAS float* wsv = aa + 64; LAS float* sc = wsv + 64;
    const bf16* QKVO = (const bf16*)(F.ws + WS_QKVO); bf16* DC = (bf16*)(F.ws + WS_DC);
    const float* IG = (const float*)(F.ws + WS_IG); const float* LF = (const float*)(F.ws + WS_LF);
    float* DN = (float*)(F.ws + WS_DN); float* BL = (float*)(F.ws + WS_BL); float* AMX = (float*)(F.ws + WS_AMX);
    const int tid = F.tid;
    for (int u = blockIdx.x; u < NUNIT; u += gridDim.x) {
        const int bh = u >> 7, c = u & 127, b = bh >> 3, h = bh & 7; const size_t row0 = (size_t)b * SEQ + c * 64;
        if (tid < 64) { gl[tid] = LF[(size_t)bh * SEQ + c * 64 + tid]; gi[tid] = IG[(size_t)bh * SEQ + c * 64 + tid]; }
        __syncthreads();
        if (tid == 0) { float s = 0.f, amax = -INFINITY; for (int t = 0; t < 64; ++t) { s += gl[t]; const float a = gi[t] - s; aa[t] = a; amax = fmaxf(amax, a); } sc[0] = amax; sc[1] = s; }
        __syncthreads();
        if (tid < 64) wsv[tid] = expf(aa[tid] - sc[0]);
        __syncthreads();
#pragma unroll 1
        for (int i = tid; i < 64 * 64; i += 512) { const int s = i >> 6, d = i & 63; Ks[s * 65 + d] = wsv[s] * bf2f(QKVO[(row0 + s) * MIN_N + KOFF + h * 64 + d]); }
#pragma unroll 1
        for (int i = tid; i < 64 * 128; i += 512) { const int s = i >> 7, d = i & 127; Vs[s * 129 + d] = bf2f(QKVO[(row0 + s) * MIN_N + VOFF + h * 128 + d]); }
        __syncthreads();
#pragma unroll 1
        for (int j = 0; j < 16; ++j) { const int e = tid + j * 512, dv = e >> 6, dk = e & 63; float a = 0.f;
            for (int s = 0; s < 64; ++s) a += Ks[s * 65 + dk] * Vs[s * 129 + dv];
            DC[(size_t)u * 8192 + e] = f2bf(a); }
        if (tid < 64) { float a = 0.f; for (int s = 0; s < 64; ++s) a += Ks[s * 65 + tid]; DN[(size_t)u * 64 + tid] = a; }
        if (tid == 0) { BL[u] = sc[1]; AMX[u] = sc[0]; }
        __syncthreads();
    }
}
__device__ __forceinline__ void mlstm_p3_scan(Frame& F) {
    const bf16* DC = (const bf16*)(F.ws + WS_DC); bf16* CS = (bf16*)(F.ws + WS_CS);
    const float* DN = (const float*)(F.ws + WS_DN); float* NS = (float*)(F.ws + WS_NS);
    const float* BL = (const float*)(F.ws + WS_BL); const float* AMX = (const float*)(F.ws + WS_AMX); float* MS = (float*)(F.ws + WS_MS);
    for (int w = blockIdx.x; w < 256; w += gridDim.x) {
        const int bh = w >> 4, sl = w & 15, e = sl * 512 + F.tid; const bool nth = (sl == 0 && F.tid < 64);
        float C = 0.f, n = 0.f, m = 0.f;
#pragma unroll 8
        for (int c = 0; c < 128; ++c) { const int u = bh * 128 + c;
            const float bl = BL[u], am = AMX[u];
            CS[(size_t)u * 8192 + e] = f2bf(C);
            if (nth) NS[(size_t)u * 64 + F.tid] = n;
            if (sl == 0 && F.tid == 0) MS[u] = m;
            const float mt = bl + am, mn = fmaxf(bl + m, mt), dec = expf(bl + m - mn), scl = expf(mt - mn);
            C = dec * C + scl * bf2f(DC[(size_t)u * 8192 + e]);
            if (nth) n = dec * n + scl * DN[(size_t)u * 64 + F.tid];
            m = mn; }
    }
}
__device__ __forceinline__ void mlstm_p4_simple(Frame& F) {
    LAS float* Qs = (LAS float*)F.lds;
    LAS float* Ks = Qs + 64 * 65;
    LAS float* Vs = Ks + 64 * 65;
    LAS float* Cs = Vs + 64 * 129;
    LAS float* Ws = Cs + 128 * 65;
    LAS float* Hs = Ws + 64 * 65;
    LAS float* gl = Hs + 64 * 129; LAS float* gi = gl + 64; LAS float* aa = gi + 64; LAS float* bb = aa + 64; LAS float* Mt = bb + 64;
    LAS float* sint = Mt + 64; LAS float* eneg = sint + 64; LAS float* dinv = eneg + 64; LAS float* rs = dinv + 64; LAS float* nv = rs + 64;
    const bf16* QKVO = (const bf16*)(F.ws + WS_QKVO); const bf16* CS = (const bf16*)(F.ws + WS_CS); bf16* G = (bf16*)(F.ws + WS_G);
    const float* IG = (const float*)(F.ws + WS_IG); const float* LF = (const float*)(F.ws + WS_LF);
    const float* NS = (const float*)(F.ws + WS_NS); const float* MS = (const float*)(F.ws + WS_MS);
    const float* hnorm = F.in(3);
    const int tid = F.tid;
    for (int u = blockIdx.x; u < NUNIT; u += gridDim.x) {
        const int bh = u >> 7, c = u & 127, b = bh >> 3, h = bh & 7; const size_t row0 = (size_t)b * SEQ + c * 64;
        const float mc = MS[u];
        if (tid < 64) { gl[tid] = LF[(size_t)bh * SEQ + c * 64 + tid]; gi[tid] = IG[(size_t)bh * SEQ + c * 64 + tid]; nv[tid] = NS[(size_t)u * 64 + tid]; }
        __syncthreads();
        if (tid == 0) { float s = 0.f, cm = mc; for (int t = 0; t < 64; ++t) { s += gl[t]; bb[t] = s; const float a = gi[t] - s; aa[t] = a; cm = fmaxf(cm, a); Mt[t] = cm; } }
        __syncthreads();
        if (tid < 64) { sint[tid] = expf(mc - Mt[tid]); eneg[tid] = expf(-bb[tid] - Mt[tid]); }
#pragma unroll 1
        for (int i = tid; i < 64 * 64; i += 512) { const int s = i >> 6, d = i & 63;
            Qs[s * 65 + d] = bf2f(QKVO[(row0 + s) * MIN_N + QOFF + h * 64 + d]); Ks[s * 65 + d] = bf2f(QKVO[(row0 + s) * MIN_N + KOFF + h * 64 + d]); }
#pragma unroll 1
        for (int i = tid; i < 64 * 128; i += 512) { const int s = i >> 7, d = i & 127; Vs[s * 129 + d] = bf2f(QKVO[(row0 + s) * MIN_N + VOFF + h * 128 + d]); }
#pragma unroll 1
        for (int i = tid; i < 128 * 64; i += 512) { const int dv = i >> 6, dk = i & 63; Cs[dv * 65 + dk] = bf2f(CS[(size_t)u * 8192 + i]); }
        __syncthreads();
#pragma unroll 1
        for (int j = 0; j < 8; ++j) { const int i = tid + j * 512, t = i >> 6, s = i & 63; float w = 0.f;
            if (s <= t) { float d = 0.f; for (int k = 0; k < 64; ++k) d += Qs[t * 65 + k] * Ks[s * 65 + k]; w = d * expf(aa[s] - Mt[t]); }
            Ws[t * 65 + s] = w; }
        __syncthreads();
        if (tid < 64) { const int t = tid; float den = 0.f, qn = 0.f; for (int s = 0; s < 64; ++s) den += Ws[t * 65 + s];
            for (int k = 0; k < 64; ++k) qn += Qs[t * 65 + k] * nv[k];
            den += sint[t] * qn; dinv[t] = 1.0f / fmaxf(fabsf(den), eneg[t]); }
        __syncthreads();
#pragma unroll 1
        for (int j = 0; j < 16; ++j) { const int i = tid + j * 512, t = i >> 7, dv = i & 127; float a = 0.f, ci = 0.f;
            for (int s = 0; s < 64; ++s) a += Ws[t * 65 + s] * Vs[s * 129 + dv];
            for (int k = 0; k < 64; ++k) ci += Qs[t * 65 + k] * Cs[dv * 65 + k];
            Hs[t * 129 + dv] = (a + sint[t] * ci) * dinv[t]; }
        __syncthreads();
        if (tid < 64) { float ss = 0.f; for (int d = 0; d < 128; ++d) { const float v = Hs[tid * 129 + d]; ss += v * v; } rs[tid] = 1.0f / sqrtf(ss * (1.0f / 128.f) + EPS); }
        __syncthreads();
#pragma unroll 1
        for (int j = 0; j < 16; ++j) { const int i = tid + j * 512, t = i >> 7, dv = i & 127;
            const float o = bf2f(QKVO[(row0 + t) * MIN_N + OOFF + h * 128 + dv]);
            const float g = Hs[t * 129 + dv] * rs[t] * hnorm[h * 128 + dv] / (1.0f + expf(-o));
            G[(row0 + t) * DM + h * 128 + dv] = f2bf(g); }
        __syncthreads();
    }
}

typedef float f32x16 __attribute__((ext_vector_type(16)));
typedef short s16x4 __attribute__((ext_vector_type(4)));
__device__ __forceinline__ s16x4 tr_read(const LAS unsigned char* p) { return __builtin_bit_cast(s16x4, __builtin_amdgcn_ds_read_tr16_b64_v4i16((LAS s16x4*)p)); }
__device__ __forceinline__ bf16x8 pack_step(const f32x16& x, int s) {
    u32x4 p; p.x = pk2(x[8 * s], x[8 * s + 1]); p.y = pk2(x[8 * s + 2], x[8 * s + 3]); p.z = pk2(x[8 * s + 4], x[8 * s + 5]); p.w = pk2(x[8 * s + 6], x[8 * s + 7]);
    return __builtin_bit_cast(bf16x8, p);
}
#define MFMA32(a, b, c) __builtin_amdgcn_mfma_f32_32x32x16_bf16((a), (b), (c), 0, 0, 0)
__device__ __forceinline__ void attn_mfma(Frame& F) {
    constexpr int KP = 144, VP = 192;
    LAS unsigned char* Kl = F.lds; LAS unsigned char* Vl = F.lds + 256 * KP;
    const bf16* QKV = (const bf16*)(F.ws + WS_AQKV); bf16* AO = (bf16*)(F.ws + WS_AO);
    const float* sinks = F.in(7);
    const int tid = F.tid, lane = F.lane, r = lane & 31, h = lane >> 5, wid = F.wave;
    const int tq = (lane & 15) >> 2, tp = lane & 3, tblk = (lane >> 4) & 1;
    for (int u = blockIdx.x; u < 256; u += gridDim.x) {
        const int b = u >> 7, kvh = (u >> 6) & 1, qb = u & 63, q0 = qb * 128; const size_t rb = (size_t)b * SEQ;
#pragma unroll
        for (int i = 0; i < 4; ++i) { const int ch = tid + i * 512, key = ch >> 3, c8 = ch & 7, kp = q0 - 128 + key;
            u32x4 kv = {0u, 0u, 0u, 0u}, vv = {0u, 0u, 0u, 0u};
            if (kp >= 0) { kv = *(const u32x4*)(QKV + (rb + kp) * AIN_N + 1024 + kvh * 64 + c8 * 8); vv = *(const u32x4*)(QKV + (rb + kp) * AIN_N + 1152 + kvh * 64 + c8 * 8); }
            *(LAS u32x4*)(Kl + key * KP + c8 * 16) = kv; *(LAS u32x4*)(Vl + key * VP + c8 * 16) = vv; }
        __syncthreads();
        const int hq = kvh * 8 + wid; const float sink = sinks[hq];
#pragma unroll 1
        for (int i = 0; i < 4; ++i) {
            const bf16* qrow = QKV + (rb + q0 + 32 * i + r) * AIN_N + hq * 64 + 8 * h;
            bf16x8 qf[4];
#pragma unroll
            for (int ks = 0; ks < 4; ++ks) qf[ks] = *(const bf16x8*)(qrow + 16 * ks);
            f32x16 sc[5];
#pragma unroll
            for (int jj = 0; jj < 5; ++jj) { f32x16 acc;
#pragma unroll
                for (int e = 0; e < 16; ++e) acc[e] = 0.f;
                const LAS unsigned char* kb = Kl + (32 * (i + jj) + r) * KP + 16 * h;
#pragma unroll
                for (int ks = 0; ks < 4; ++ks) { const bf16x8 kf = *(const LAS bf16x8*)(kb + 32 * ks); acc = MFMA32(kf, qf[ks], acc); }
                sc[jj] = acc; }
            float mx = sink;
#pragma unroll
            for (int jj = 0; jj < 5; ++jj) { const bool dead = (qb == 0) && (i + jj < 4);
#pragma unroll
                for (int e = 0; e < 16; ++e) { const int kr = (e & 3) + 8 * (e >> 2) + 4 * h; bool ok = !dead;
                    if (jj == 0) ok = ok && (kr > r);
                    if (jj == 4) ok = ok && (kr <= r);
                    const float v = ok ? sc[jj][e] : -INFINITY; sc[jj][e] = v; mx = fmaxf(mx, v); } }
            mx = fmaxf(mx, shx(mx, 32, lane));
            float sum = 0.f;
#pragma unroll
            for (int jj = 0; jj < 5; ++jj)
#pragma unroll
                for (int e = 0; e < 16; ++e) { const float p = __expf(sc[jj][e] - mx); sc[jj][e] = p; sum += p; }
            sum += shx(sum, 32, lane);
            const float inv = 1.0f / (sum + __expf(sink - mx));
            f32x16 o0, o1;
#pragma unroll
            for (int e = 0; e < 16; ++e) { o0[e] = 0.f; o1[e] = 0.f; }
#pragma unroll
            for (int jj = 0; jj < 5; ++jj)
#pragma unroll
                for (int ks = 0; ks < 2; ++ks) { const bf16x8 pb = pack_step(sc[jj], ks);
                    const LAS unsigned char* vb = Vl + (32 * (i + jj) + 16 * ks + 4 * h + tq) * VP + (16 * tblk + 4 * tp) * 2;
                    { const s16x4 lo = tr_read(vb), hi = tr_read(vb + 8 * VP); const bf16x8 va = __builtin_shufflevector(lo, hi, 0, 1, 2, 3, 4, 5, 6, 7); o0 = MFMA32(va, pb, o0); }
                    { const s16x4 lo = tr_read(vb + 64), hi = tr_read(vb + 8 * VP + 64); const bf16x8 va = __builtin_shufflevector(lo, hi, 0, 1, 2, 3, 4, 5, 6, 7); o1 = MFMA32(va, pb, o1); } }
            bf16* orow = AO + (rb + q0 + 32 * i + r) * DM + hq * 64 + 4 * h;
#pragma unroll
            for (int g4 = 0; g4 < 4; ++g4) {
                u32x2 w0, w1; w0.x = pk2(o0[4 * g4] * inv, o0[4 * g4 + 1] * inv); w0.y = pk2(o0[4 * g4 + 2] * inv, o0[4 * g4 + 3] * inv);
                w1.x = pk2(o1[4 * g4] * inv, o1[4 * g4 + 1] * inv); w1.y = pk2(o1[4 * g4 + 2] * inv, o1[4 * g4 + 3] * inv);
                *(u32x2*)(orow + 8 * g4) = w0; *(u32x2*)(orow + 32 + 8 * g4) = w1; }
        }
        __syncthreads();
    }
}

__device__ __forceinline__ float scan_add(float v, int lane) {
#pragma unroll
    for (int d = 1; d < 64; d <<= 1) { const float t = shi(v, (lane - d) & 63); if (lane >= d) v += t; }
    return v;
}
__device__ __forceinline__ float scan_max(float v, int lane) {
#pragma unroll
    for (int d = 1; d < 64; d <<= 1) { const float t = shi(v, (lane - d) & 63); if (lane >= d) v = fmaxf(v, t); }
    return v;
}
__device__ __forceinline__ float wave_max(float v, int lane) {
#pragma unroll
    for (int o = 1; o < 64; o <<= 1) v = fmaxf(v, shx(v, o, lane));
    return v;
}
__device__ __forceinline__ int swz128(int row, int cb) { return row * 128 + (cb ^ (((row >> 1) & 1) << 6)); }
__device__ __forceinline__ u32x4 scale8(u32x4 v, float s) {
    u32x4 o;
#pragma unroll
    for (int i = 0; i < 4; ++i) { const unsigned w = v[i]; o[i] = pk2(__uint_as_float(w << 16) * s, __uint_as_float(w & 0xffff0000u) * s); }
    return o;
}
__device__ __forceinline__ void mlstm_p2_mfma(Frame& F) {
    LAS unsigned char* Kl = F.lds + F.wave * 16384; LAS unsigned char* Vl = Kl + 8192;
    const bf16* QKVO = (const bf16*)(F.ws + WS_QKVO); bf16* DC = (bf16*)(F.ws + WS_DC);
    const float* IG = (const float*)(F.ws + WS_IG); const float* LF = (const float*)(F.ws + WS_LF);
    float* DN = (float*)(F.ws + WS_DN); float* BL = (float*)(F.ws + WS_BL); float* AMX = (float*)(F.ws + WS_AMX);
    const int lane = F.lane, r = lane & 31, h = lane >> 5, tq = (lane & 15) >> 2, tp = lane & 3, tblk = (lane >> 4) & 1;
    for (int u = blockIdx.x * 8 + F.wave; u < NUNIT; u += gridDim.x * 8) {
        const int bh = u >> 7, c = u & 127, b = bh >> 3, hh = bh & 7; const size_t row0 = (size_t)b * SEQ + c * 64;
        const float lf = LF[(size_t)bh * SEQ + c * 64 + lane], ig = IG[(size_t)bh * SEQ + c * 64 + lane];
        const float bs = scan_add(lf, lane), av = ig - bs, amax = wave_max(av, lane), wsv = expf(av - amax), bL = shi(bs, 63);
#pragma unroll
        for (int i = 0; i < 8; ++i) { const int id = lane + 64 * i, row = id >> 3, c8 = id & 7;
            const u32x4 kv = *(const u32x4*)(QKVO + (row0 + row) * MIN_N + KOFF + hh * 64 + c8 * 8);
            *(LAS u32x4*)(Kl + swz128(row, c8 * 16)) = scale8(kv, shi(wsv, row)); }
        bf16x8 ka[2][4];
#pragma unroll
        for (int dkb = 0; dkb < 2; ++dkb)
#pragma unroll
            for (int ks = 0; ks < 4; ++ks) { const int row = 16 * ks + 8 * h + tq, cb = (32 * dkb + 16 * tblk + 4 * tp) * 2;
                const s16x4 lo = tr_read(Kl + swz128(row, cb)), hi = tr_read(Kl + swz128(row + 4, cb));
                ka[dkb][ks] = __builtin_shufflevector(lo, hi, 0, 1, 2, 3, 4, 5, 6, 7); }
        { const short one = (r == 0) ? (short)0x3F80 : (short)0; const bf16x8 onesB = {one, one, one, one, one, one, one, one};
#pragma unroll
          for (int dkb = 0; dkb < 2; ++dkb) { f32x16 acc;
#pragma unroll
              for (int e = 0; e < 16; ++e) acc[e] = 0.f;
#pragma unroll
              for (int ks = 0; ks < 4; ++ks) acc = MFMA32(ka[dkb][ks], onesB, acc);
              if (r == 0) {
#pragma unroll
                  for (int e = 0; e < 16; ++e) DN[(size_t)u * 64 + 32 * dkb + (e & 3) + 8 * (e >> 2) + 4 * h] = acc[e]; } } }
#pragma unroll 1
        for (int half = 0; half < 2; ++half) {
#pragma unroll
            for (int i = 0; i < 8; ++i) { const int id = lane + 64 * i, row = id >> 3, c8 = id & 7;
                *(LAS u32x4*)(Vl + swz128(row, c8 * 16)) = *(const u32x4*)(QKVO + (row0 + row) * MIN_N + VOFF + hh * 128 + half * 64 + c8 * 8); }
#pragma unroll
            for (int dvb2 = 0; dvb2 < 2; ++dvb2) { f32x16 acc0, acc1;
#pragma unroll
                for (int e = 0; e < 16; ++e) { acc0[e] = 0.f; acc1[e] = 0.f; }
#pragma unroll
                for (int ks = 0; ks < 4; ++ks) { const int row = 16 * ks + 8 * h + tq, cb = (32 * dvb2 + 16 * tblk + 4 * tp) * 2;
                    const s16x4 lo = tr_read(Vl + swz128(row, cb)), hi = tr_read(Vl + swz128(row + 4, cb));
                    const bf16x8 vb = __builtin_shufflevector(lo, hi, 0, 1, 2, 3, 4, 5, 6, 7);
                    acc0 = MFMA32(ka[0][ks], vb, acc0); acc1 = MFMA32(ka[1][ks], vb, acc1); }
                bf16* drow = DC + (size_t)u * 8192 + (size_t)(64 * half + 32 * dvb2 + r) * 64 + 4 * h;
#pragma unroll
                for (int g4 = 0; g4 < 4; ++g4) { u32x2 w0, w1;
                    w0.x = pk2(acc0[4 * g4], acc0[4 * g4 + 1]); w0.y = pk2(acc0[4 * g4 + 2], acc0[4 * g4 + 3]);
                    w1.x = pk2(acc1[4 * g4], acc1[4 * g4 + 1]); w1.y = pk2(acc1[4 * g4 + 2], acc1[4 * g4 + 3]);
                    *(u32x2*)(drow + 8 * g4) = w0; *(u32x2*)(drow + 32 + 8 * g4) = w1; } }
        }
        if (lane == 0) { BL[u] = bL; AMX[u] = amax; }
    }
}
__device__ __forceinline__ void mlstm_p4_mfma(Frame& F) {
    LAS unsigned char* Vl = F.lds + F.wave * 16384;
    const unsigned char* QKVOb = F.ws + WS_QKVO; const unsigned char* CSb = F.ws + WS_CS; unsigned char* Gb = F.ws + WS_G;
    const float* IG = (const float*)(F.ws + WS_IG); const float* LF = (const float*)(F.ws + WS_LF);
    const float* NS = (const float*)(F.ws + WS_NS); const float* MS = (const float*)(F.ws + WS_MS);
    const float* hnorm = F.in(3);
    for (int u = blockIdx.x * 8 + F.wave; u < NUNIT; u += gridDim.x * 8) {
        int lane = F.lane; asm volatile("" : "+v"(lane));
        int r = lane & 31, h = lane >> 5, tq = (lane & 15) >> 2, tp = lane & 3, tblk = (lane >> 4) & 1;
        const int bh = u >> 7, c = u & 127, b = bh >> 3, hh = bh & 7; const unsigned row0 = (unsigned)(b * SEQ + c * 64);
        const float mc = MS[u];
        const float lf = LF[(size_t)bh * SEQ + c * 64 + lane], ig = IG[(size_t)bh * SEQ + c * 64 + lane];
        const float bs = scan_add(lf, lane), av = ig - bs, Mt = fmaxf(mc, scan_max(av, lane));
        const float sint = expf(mc - Mt), eneg = expf(-bs - Mt);
        const unsigned char* ubase = QKVOb + (size_t)row0 * (MIN_N * 2);
#pragma unroll
        for (int i = 0; i < 16; ++i) { const int id = lane + 64 * i, row = id >> 4, c16 = id & 15;
            *(LAS u32x4*)(Vl + (c16 >> 3) * 8192 + swz128(row, (c16 & 7) * 16)) = *(const u32x4*)(ubase + (unsigned)(row * (MIN_N * 2) + (VOFF + hh * 128 + c16 * 8) * 2)); }
        #pragma unroll 1
        for (int tb = 0; tb < 2; ++tb) {
            asm volatile("" : "+v"(lane)); r = lane & 31; h = lane >> 5; tq = (lane & 15) >> 2; tp = lane & 3; tblk = (lane >> 4) & 1;
            const int t = 32 * tb + r;
            const float Mt_t = shi(Mt, t), sint_t = shi(sint, t), eneg_t = shi(eneg, t);
            const unsigned toff = (unsigned)(t * (MIN_N * 2));
            u32x4 qv[4];
#pragma unroll
            for (int ks = 0; ks < 4; ++ks) qv[ks] = *(const u32x4*)(ubase + (toff + (unsigned)((QOFF + hh * 64 + 16 * ks + 8 * h) * 2)));
            const short one = (r == 0) ? (short)0x3F80 : (short)0; const bf16x8 onesA = {one, one, one, one, one, one, one, one};
            f32x16 num[4], den;
#pragma unroll
            for (int e = 0; e < 16; ++e) { num[0][e] = 0.f; num[1][e] = 0.f; num[2][e] = 0.f; num[3][e] = 0.f; den[e] = 0.f; }
#pragma unroll 1
            for (int sb = 0; sb <= tb; ++sb) {
                f32x16 acc;
#pragma unroll
                for (int e = 0; e < 16; ++e) acc[e] = 0.f;
                const unsigned koff = (unsigned)((32 * sb + r) * (MIN_N * 2) + (KOFF + hh * 64 + 8 * h) * 2);
#pragma unroll
                for (int ks = 0; ks < 4; ++ks) { const bf16x8 kf = *(const bf16x8*)(ubase + (koff + 32u * ks)); acc = MFMA32(kf, __builtin_bit_cast(bf16x8, qv[ks]), acc); }
#pragma unroll
                for (int e = 0; e < 16; ++e) { const int kr = (e & 3) + 8 * (e >> 2) + 4 * h; const float a_s = shi(av, 32 * sb + kr);
                    const bool dead = (sb == tb) && (kr > r);
                    acc[e] = dead ? 0.f : acc[e] * __expf(a_s - Mt_t); }
#pragma unroll
                for (int ks2 = 0; ks2 < 2; ++ks2) { const bf16x8 pb = pack_step(acc, ks2);
                    const int row = 32 * sb + 16 * ks2 + 4 * h + tq;
#pragma unroll
                    for (int dvb = 0; dvb < 4; ++dvb) { const LAS unsigned char* vb = Vl + (dvb >> 1) * 8192; const int cb = (32 * (dvb & 1) + 16 * tblk + 4 * tp) * 2;
                        const s16x4 lo = tr_read(vb + swz128(row, cb)), hi = tr_read(vb + swz128(row + 8, cb));
                        const bf16x8 va = __builtin_shufflevector(lo, hi, 0, 1, 2, 3, 4, 5, 6, 7); num[dvb] = MFMA32(va, pb, num[dvb]); }
                    den = MFMA32(onesA, pb, den); }
            }
            const unsigned char* cbase = CSb + (size_t)u * 16384;
#pragma unroll
            for (int ks = 0; ks < 4; ++ks) {
                const bf16x8 sq = __builtin_bit_cast(bf16x8, scale8(qv[ks], sint_t));
                u32x4 nw = {0u, 0u, 0u, 0u};
                if (r == 0) { const f32x4 n0 = *(const f32x4*)(NS + (size_t)u * 64 + 16 * ks + 8 * h), n1 = *(const f32x4*)(NS + (size_t)u * 64 + 16 * ks + 8 * h + 4);
                    nw.x = pk2(n0.x, n0.y); nw.y = pk2(n0.z, n0.w); nw.z = pk2(n1.x, n1.y); nw.w = pk2(n1.z, n1.w); }
#pragma unroll
                for (int dvb = 0; dvb < 4; ++dvb) { const bf16x8 ca = *(const bf16x8*)(cbase + (unsigned)((32 * dvb + r) * 128 + (16 * ks + 8 * h) * 2)); num[dvb] = MFMA32(ca, sq, num[dvb]); }
                den = MFMA32(__builtin_bit_cast(bf16x8, nw), sq, den); }
            const float dent = shi(den[0], r);
            const float dinv = 1.0f / fmaxf(fabsf(dent), eneg_t);
            float ssq = 0.f;
#pragma unroll
            for (int dvb = 0; dvb < 4; ++dvb)
#pragma unroll
                for (int e = 0; e < 16; ++e) { const float v = num[dvb][e] * dinv; num[dvb][e] = v; ssq += v * v; }
            ssq += shx(ssq, 32, lane);
            const float rstd = 1.0f / sqrtf(ssq * (1.0f / 128.f) + EPS);
            const unsigned ooff = toff + (unsigned)((OOFF + hh * 128 + 4 * h) * 2);
            unsigned char* gbase = Gb + (size_t)row0 * (DM * 2); const unsigned goff = (unsigned)(t * (DM * 2) + (hh * 128 + 4 * h) * 2);
            const float* hrow = hnorm + hh * 128 + 4 * h;
#pragma unroll
            for (int dvb = 0; dvb < 4; ++dvb)
#pragma unroll
                for (int g4 = 0; g4 < 4; ++g4) { const int dv = 32 * dvb + 8 * g4;
                    const u32x2 ov = *(const u32x2*)(ubase + (ooff + 2u * dv)); const f32x4 hn = *(const f32x4*)(hrow + dv);
                    const float o0 = __uint_as_float(ov.x << 16), o1 = __uint_as_float(ov.x & 0xffff0000u), o2 = __uint_as_float(ov.y << 16), o3 = __uint_as_float(ov.y & 0xffff0000u);
                    u32x2 w; w.x = pk2(num[dvb][4 * g4] * rstd * hn.x / (1.0f + __expf(-o0)), num[dvb][4 * g4 + 1] * rstd * hn.y / (1.0f + __expf(-o1)));
                    w.y = pk2(num[dvb][4 * g4 + 2] * rstd * hn.z / (1.0f + __expf(-o2)), num[dvb][4 * g4 + 3] * rstd * hn.w / (1.0f + __expf(-o3)));
                    *(u32x2*)(gbase + (goff + 2u * dv)) = w;
                    if (g4 & 1) asm volatile("" ::: "memory"); }
        }
    }
}

__device__ __forceinline__ void norm_res_rows(Frame& F, const float* Z, const float* bias, const float* base, const float* gpost, float* out, bf16* XN) {
    const int gw = blockIdx.x * 8 + F.wave, NGW = gridDim.x * 8;
    for (int m = gw; m < M; m += NGW) {
        const f32x4* zr = (const f32x4*)(Z + (size_t)m * DM) + F.lane; const f32x4* br = (const f32x4*)(base + (size_t)m * DM) + F.lane;
        f32x4 z[4], x1[4]; float ss = 0.f;
#pragma unroll
        for (int j = 0; j < 4; ++j) { z[j] = zr[64 * j]; if (bias) z[j] = z[j] + ((const f32x4*)bias)[F.lane + 64 * j];
            ss += (z[j].x * z[j].x + z[j].y * z[j].y) + (z[j].z * z[j].z + z[j].w * z[j].w); }
        const float r1 = 1.0f / sqrtf(wave_sum(ss, F.lane) * (1.0f / DM) + EPS); float s2 = 0.f;
#pragma unroll
        for (int j = 0; j < 4; ++j) { const f32x4 g = ((const f32x4*)gpost)[F.lane + 64 * j]; x1[j] = br[64 * j] + z[j] * r1 * g;
            s2 += (x1[j].x * x1[j].x + x1[j].y * x1[j].y) + (x1[j].z * x1[j].z + x1[j].w * x1[j].w); }
        f32x4* orow = (f32x4*)(out + (size_t)m * DM) + F.lane;
#pragma unroll
        for (int j = 0; j < 4; ++j) orow[64 * j] = x1[j];
        if (XN) { const float r2 = 1.0f / sqrtf(wave_sum(s2, F.lane) * (1.0f / DM) + EPS);
            unsigned long long* o8 = (unsigned long long*)(XN + (size_t)m * DM) + F.lane;
#pragma unroll
            for (int j = 0; j < 4; ++j) o8[64 * j] = (unsigned long long)pk2(x1[j].x * r2, x1[j].y * r2) | ((unsigned long long)pk2(x1[j].z * r2, x1[j].w * r2) << 32); }
    }
}

#define XB_TMO      128
#define XB_XCNT(j)  (256  + 64 * (j))
#define XB_XSUB(j)  (1280 + 64 * (j))
#define XB_XGEN(j)  (2304 + 64 * (j))
#define XB_TOP      3328
#define XB_TOPGEN   3392
#define XCD_BAR_WORDS 3456
#define XB_SPIN_CAP (1u << 20)
__device__ __forceinline__ unsigned xb_ld(unsigned* p)              { return __hip_atomic_load(p, __ATOMIC_RELAXED, __HIP_MEMORY_SCOPE_AGENT); }
__device__ __forceinline__ unsigned xb_add(unsigned* p, unsigned v) { return __hip_atomic_fetch_add(p, v, __ATOMIC_RELAXED, __HIP_MEMORY_SCOPE_AGENT); }
__device__ __forceinline__ unsigned xb_xcc_id() { return (unsigned)__builtin_amdgcn_s_getreg((3 << 11) | 20) & 0xFu; }
#define XB_SPIN(cond, bar) do { unsigned _sp = 0; while (cond) { __builtin_amdgcn_s_sleep(1); \
    if ((++_sp & 255u) == 0u) { if (xb_ld(&(bar)[XB_TMO])) break; if (_sp > XB_SPIN_CAP) { atomicAdd(&(bar)[XB_TMO], 1u); break; } } } } while (0)
struct XcdBarrier { unsigned* bar; unsigned x; volatile LAS unsigned* st; };
__device__ __forceinline__ XcdBarrier xcd_barrier_post(unsigned* bar, volatile LAS unsigned* st) {
    XcdBarrier b; b.bar = bar; b.x = xb_xcc_id(); b.st = st;
    if (threadIdx.x == 0) (void)xb_add(&bar[XB_XCNT(b.x)], 1u);
    return b;
}
__device__ __forceinline__ void xcd_barrier_complete(unsigned* bar, unsigned x, unsigned& nloc, unsigned& nx) {
    const unsigned G = gridDim.x * gridDim.y * gridDim.z;
    unsigned sum, cnt, mine, sp = 0u;
    for (;;) {
        sum = 0u; cnt = 0u; mine = 0u;
#pragma unroll
        for (unsigned j = 0; j < 16; ++j) { const unsigned c = xb_ld(&bar[XB_XCNT(j)]); sum += c; cnt += (c > 0u) ? 1u : 0u; mine = (j == x) ? c : mine; }
        if (sum == G) break;
        __builtin_amdgcn_s_sleep(1);
        if ((++sp & 255u) == 0u) { if (xb_ld(&bar[XB_TMO])) break; if (sp > XB_SPIN_CAP) { atomicAdd(&bar[XB_TMO], 1u); break; } }
    }
    nloc = mine > 0u ? mine : 1u; nx = cnt > 0u ? cnt : 1u;
}
__device__ __forceinline__ void xcd_barrier(const XcdBarrier& b) {
    asm volatile("s_waitcnt vmcnt(0)" ::: "memory");
    __syncthreads();
    if (threadIdx.x == 0) {
        unsigned* bar = b.bar; unsigned bx = b.x; asm volatile("" : "+s"(bar), "+s"(bx));
        __builtin_amdgcn_s_waitcnt(0);
        unsigned nloc = b.st[0], nx = b.st[1];
        if (nloc == 0u) { xcd_barrier_complete(bar, bx, nloc, nx); b.st[0] = nloc; b.st[1] = nx; }
        const unsigned old = xb_add(&bar[XB_XSUB(bx)], 1u);
        const unsigned gen = old / nloc;
        if (old + 1u == (gen + 1u) * nloc) {
            __builtin_amdgcn_fence(__ATOMIC_RELEASE, "agent");
            asm volatile("s_waitcnt vmcnt(0)" ::: "memory");
            const unsigned og = xb_add(&bar[XB_TOP], 1u);
            const unsigned tg = og / nx;
            if (og + 1u == (tg + 1u) * nx) xb_add(&bar[XB_TOPGEN], 1u);
            else XB_SPIN(xb_ld(&bar[XB_TOPGEN]) == tg, bar);
            __builtin_amdgcn_fence(__ATOMIC_ACQUIRE, "agent");
            xb_add(&bar[XB_XGEN(bx)], 1u);
            asm volatile("s_waitcnt vmcnt(0)" ::: "memory");
        } else {
            XB_SPIN(xb_ld(&bar[XB_XGEN(bx)]) == gen, bar);
            __builtin_amdgcn_fence(__ATOMIC_ACQUIRE, "agent");
            asm volatile("s_waitcnt vmcnt(0)" ::: "memory");
        }
    }
    __syncthreads();
}

constexpr int MISC_OFF = LDS_BYTES - 256;
constexpr int PTAB_OFF = LDS_BYTES - 512;
constexpr int CW_BAR = 4096;
constexpr size_t CTL_ZERO_BYTES = 256 * 1024;

enum Kind { K_PRO = 0, K_GEMM_BF16, K_GEMM_F32, K_GEMM_CONV, K_M2, K_M3, K_M4, K_ATT, K_NR };
struct Step { int kind, bar; unsigned a, b, c, d; int nM, nN, K, i0, e0, i1, e1, x; };
#define U(x) ((unsigned)(x))
#define FFN_STEPS(L, WUP, WDN) \
    {K_GEMM_BF16, 1, U(WS_XN), U(WUP), U(WS_GT), U(DFF), 32, 11, DM, -1, 0, 0, 0, 0}, \
    {K_GEMM_CONV, 1, U(WS_XN), U(WUP + (size_t)DFF * DM * 2), U(WS_GT), U(WS_ACT), 32, 11, DM, 15, (L) * 3 * DFF, 16, (L) * DFF, 0}, \
    {K_GEMM_F32, 1, U(WS_ACT), U(WDN), U(WS_Z), 0, 32, 4, DFF, 0, 0, 0, 0, 0}, \
    {K_GEMM_BF16, 1, U(WS_XN + (size_t)SEQ * DM * 2), U(WUP), U(WS_GT), U(DFF), 32, 11, DM, -1, 0, 0, 0, 0}, \
    {K_GEMM_CONV, 1, U(WS_XN + (size_t)SEQ * DM * 2), U(WUP + (size_t)DFF * DM * 2), U(WS_GT), U(WS_ACT), 32, 11, DM, 15, (L) * 3 * DFF, 16, (L) * DFF, 0}, \
    {K_GEMM_F32, 1, U(WS_ACT), U(WDN), U(WS_Z + (size_t)SEQ * DM * 4), 0, 32, 4, DFF, 0, 0, 0, 0, 0}
__constant__ Step g_prog[] = {
    {K_PRO, 1, 0, 0, 0, 0, 0, 0, 0, 0, 0, 0, 0, 0},
    {K_GEMM_BF16, 1, U(WS_XN), U(WS_WMIN), U(WS_QKVO), U(MIN_N), 64, 12, DM, -1, 0, 0, 0, 0},
    {K_M2, 1, 0, 0, 0, 0, 0, 0, 0, 0, 0, 0, 0, 0},
    {K_M3, 1, 0, 0, 0, 0, 0, 0, 0, 0, 0, 0, 0, 0},
    {K_M4, 1, 0, 0, 0, 0, 0, 0, 0, 0, 0, 0, 0, 0},
    {K_GEMM_F32, 1, U(WS_G), U(WS_WMOUT), U(WS_Z), 0, 64, 4, DM, 0, 0, 0, 0, 0},
    {K_NR, 1, 0, 0, U(WS_Z), 0, 0, 0, 0, -1, 0, 11, 0, 2},
    FFN_STEPS(0, WS_WUP0, WS_WDN0),
    {K_NR, 1, 0, 0, U(WS_Z), 0, 0, 0, 0, -1, 0, 13, 0, 3},
    {K_GEMM_BF16, 1, U(WS_XN), U(WS_WAIN), U(WS_AQKV), U(AIN_N), 64, 5, DM, 6, 0, 0, 0, 1024},
    {K_ATT, 1, 0, 0, 0, 0, 0, 0, 0, 0, 0, 0, 0, 0},
    {K_GEMM_F32, 1, U(WS_AO), U(WS_WAOUT), U(WS_Z), 0, 64, 4, DM, 0, 0, 0, 0, 0},
    {K_NR, 1, 0, 0, U(WS_Z), 0, 0, 0, 0, 9, 0, 11, DM, 3},
    FFN_STEPS(1, WS_WUP1, WS_WDN1),
    {K_NR, 0, 0, 0, U(WS_Z), 0, 0, 0, 0, -1, 0, 13, DM, 1},
};
constexpr int NSTEPS = 1 + 6 + 6 + 1 + 4 + 6 + 1;

__global__ void __launch_bounds__(512, 2) skel_fwd(Args args) {
    extern __shared__ __attribute__((aligned(16))) unsigned char lds[];
    Frame F;
    F.lds = (LAS unsigned char*)lds; F.tid = threadIdx.x; F.lane = F.tid & 63; F.wave = __builtin_amdgcn_readfirstlane(F.tid >> 6); F.G = gridDim.x;
    F.ws = args.ws;
    unsigned char* ws = args.ws;
    volatile LAS unsigned* MISC = (volatile LAS unsigned*)(F.lds + MISC_OFF);
    if (F.tid < 64) MISC[F.tid] = 0u;
    if (F.tid < 19) ((LAS unsigned long long*)(F.lds + PTAB_OFF))[F.tid] = (F.tid < 18) ? (unsigned long long)args.in[F.tid] : (unsigned long long)args.out;
    __syncthreads();
    XcdBarrier bar = xcd_barrier_post((unsigned*)(ws + WS_CTL) + CW_BAR, MISC + 8);
#pragma unroll 1
    for (int si = 0; si < NSTEPS; ++si) {
        const Step st = g_prog[si];
        { int t_ = threadIdx.x; asm volatile("" : "+v"(t_)); F.tid = t_; F.lane = t_ & 63; F.wave = __builtin_amdgcn_readfirstlane(t_ >> 6);
          unsigned char* w_ = args.ws; asm volatile("" : "+s"(w_)); F.ws = w_; ws = w_; }
        switch (st.kind) {
        case K_PRO: p0_prologue(F); break;
        case K_GEMM_BF16: { EpiBf16 E{(bf16*)(ws + st.c), (int)st.d, st.i0 >= 0 ? F.in(st.i0) + st.e0 : nullptr, st.x, 0.125f};
            pg8::Gemm g{(const bf16*)(ws + st.a), (const bf16*)(ws + st.b), st.nM * 256, st.nN * 256, st.K}; pg8::StaticOrder S; S.init(g.M, g.N, F.G, (int)blockIdx.x);
            pg8::gemm_phase<decltype(E), pg8::StaticOrder, true, true>(F.lds, g, S, E); } break;
        case K_GEMM_F32: { EpiF32 E{(float*)(ws + st.c), DM}; pg8::Gemm g{(const bf16*)(ws + st.a), (const bf16*)(ws + st.b), st.nM * 256, st.nN * 256, st.K}; pg8::StaticOrder S; S.init(g.M, g.N, F.G, (int)blockIdx.x);
            pg8::gemm_phase<decltype(E), pg8::StaticOrder, true, true>(F.lds, g, S, E); } break;
        case K_GEMM_CONV: { EpiConv E{(const bf16*)(ws + st.c), (bf16*)(ws + st.d), F.in(st.i0) + st.e0, F.in(st.i1) + st.e1};
            pg8::Gemm g{(const bf16*)(ws + st.a), (const bf16*)(ws + st.b), st.nM * 256, st.nN * 256, st.K}; pg8::StaticOrder S; S.init(g.M, g.N, F.G, (int)blockIdx.x);
            pg8::gemm_phase<decltype(E), pg8::StaticOrder, true, true>(F.lds, g, S, E); } break;
        case K_M2: mlstm_p2_mfma(F); break;
        case K_M3: mlstm_p3_scan(F); break;
        case K_M4: mlstm_p4_mfma(F); break;
        case K_ATT: attn_mfma(F); break;
        case K_NR: norm_res_rows(F, (const float*)(ws + st.c), st.i0 >= 0 ? F.in(st.i0) + st.e0 : nullptr, (st.x & 1) ? (const float*)F.out() : F.in(0), F.in(st.i1) + st.e1, F.out(), (st.x & 2) ? (bf16*)(ws + WS_XN) : nullptr); break;
        default: break;
        }
        if (st.bar) xcd_barrier(bar);
    }
}

extern "C" void kernel_launch(void* const* d_in, const int* in_sizes, int n_in, void* d_out, int out_size, void* d_ws, size_t ws_size, hipStream_t stream) {
    static int grid = 0;
    if (grid == 0) {
        if (n_in != 18 || in_sizes[0] != M * DM || out_size != M * DM || ws_size < WS_END) { fprintf(stderr, "kernel_launch: unexpected shapes (n_in %d, in0 %d, out %d, ws %zu)\n", n_in, n_in > 0 ? in_sizes[0] : -1, out_size, ws_size); grid = -1; return; }
        int dev = 0, cus = 0, per_cu = 0;
        (void)hipGetDevice(&dev); (void)hipDeviceGetAttribute(&cus, hipDeviceAttributeMultiprocessorCount, dev);
        if (hipFuncSetAttribute((const void*)skel_fwd, hipFuncAttributeMaxDynamicSharedMemorySize, LDS_BYTES) != hipSuccess) { fprintf(stderr, "kernel_launch: hipFuncSetAttribute failed\n"); grid = -1; return; }
        if (hipOccupancyMaxActiveBlocksPerMultiprocessor(&per_cu, (const void*)skel_fwd, 512, LDS_BYTES) != hipSuccess || per_cu < 1) { fprintf(stderr, "kernel_launch: occupancy query says %d blocks per CU\n", per_cu); per_cu = 1; }
        (void)hipGetLastError();
        grid = cus > 0 ? cus : 256;
    }
    if (grid < 0) return;
    (void)hipMemsetAsync((char*)d_ws + WS_CTL, 0, CTL_ZERO_BYTES, stream);
    Args a{};
    for (int i = 0; i < 18; ++i) a.in[i] = (const float*)d_in[i];
    a.out = (float*)d_out; a.ws = (unsigned char*)d_ws;
    hipLaunchKernelGGL(skel_fwd, dim3(grid), dim3(512), LDS_BYTES, stream, a);
}
```
